# Optimizing an MI355X kernel written in HIP

```python
import math
import jax, jax.numpy as jnp
from jax import lax
import numpy as np

D_MODEL = 1024
BATCH = 4
SEQ = 8192
DEPTH = 2

N_META = 16
CHUNK = 128
PAD = CHUNK - N_META
EPS = 1e-6
NEG_INF = -1e30
D_FF = 2816

FOX_HEADS = 8
FOX_DIM = 64
FOX_W = FOX_HEADS * FOX_DIM
GDN_HEADS = 4
GDN_DK = 128
GDN_DV = 128
GDN_CONV = 4
GDN_QKW = GDN_HEADS * GDN_DK
GDN_VW = GDN_HEADS * GDN_DV
GDN_QKV = 2 * GDN_QKW + GDN_VW
HYB_SIZES = (FOX_W, FOX_W, FOX_W, FOX_HEADS, GDN_QKV, GDN_HEADS, GDN_HEADS, GDN_VW)
HYB_IN = 3 * FOX_W + FOX_HEADS + GDN_QKV + 2 * GDN_HEADS + GDN_VW
MIX_W = FOX_W + GDN_VW
RWKV_HEAD = 64
RWKV_HEADS = D_MODEL // RWKV_HEAD
RWKV_DECAY_LORA = 64
RWKV_A_LORA = 64
RWKV_GATE_LORA = 160
RWKV_GN_EPS = 64e-5

kernel_name = 'hybrid_fox_gdn_rwkv7_macaron'


def rms_norm(x, gain):
    x32 = x.astype(jnp.float32)
    y = x32 * lax.rsqrt(jnp.mean(x32 * x32, axis=-1, keepdims=True) + EPS)
    return (y * gain.astype(jnp.float32)).astype(x.dtype)


def l2_normalize(x):
    x32 = x.astype(jnp.float32)
    return x32 * lax.rsqrt(jnp.sum(x32 * x32, axis=-1, keepdims=True) + EPS)


def swiglu_ffn(h, w_in, w_out):
    gate, up = jnp.split(h @ w_in, 2, axis=-1)
    return (jax.nn.silu(gate) * up) @ w_out


def split_cols(z, sizes):
    return jnp.split(z, [int(s) for s in np.cumsum(sizes)[:-1]], axis=-1)


def to_heads(t, n, d):
    B_, L, _ = t.shape
    return t.reshape(B_, L, n, d).transpose(0, 2, 1, 3).astype(jnp.float32)


def pad_seq(t):
    widths = [(0, 0)] * t.ndim
    widths[2] = (PAD, 0)
    return jnp.pad(t, widths)


def causal_depthwise_conv(x, w):
    K = w.shape[0]
    L = x.shape[1]
    xp = jnp.pad(x, ((0, 0), (K - 1, 0), (0, 0)))
    y = xp[:, 0:L] * w[0]
    for j in range(1, K):
        y = y + xp[:, j:j + L] * w[j]
    return y


def forgetting_attention(q, k, v, log_f):
    B_, H, LP, Dh = q.shape
    n_blocks = LP // CHUNK
    c = jnp.cumsum(log_f, axis=-1)
    kpos = jnp.arange(LP)
    scale = Dh ** -0.5

    def block(i):
        start = i * CHUNK
        qb = lax.dynamic_slice_in_dim(q, start, CHUNK, axis=2)
        cb = lax.dynamic_slice_in_dim(c, start, CHUNK, axis=2)
        qpos = start + jnp.arange(CHUNK)
        logits = jnp.einsum('bhqd,bhkd->bhqk', qb, k) * scale + cb[..., :, None] - c[..., None, :]
        valid = (kpos[None, :] <= qpos[:, None]) & (kpos[None, :] >= PAD)
        p = jax.nn.softmax(jnp.where(valid, logits, NEG_INF), axis=-1)
        return jnp.einsum('bhqk,bhkd->bhqd', p, v)

    out = lax.map(block, jnp.arange(n_blocks))
    return jnp.moveaxis(out, 0, 2).reshape(B_, H, LP, Dh)


def gated_delta_rule(q, k, v, log_g, beta):
    B_, H, LP, Dk = q.shape
    Dv = v.shape[-1]
    nc = LP // CHUNK
    q = (q * Dk ** -0.5).reshape(B_, H, nc, CHUNK, Dk)
    k = k.reshape(B_, H, nc, CHUNK, Dk)
    v = v.reshape(B_, H, nc, CHUNK, Dv)
    beta = beta.reshape(B_, H, nc, CHUNK)
    gc = jnp.cumsum(log_g.reshape(B_, H, nc, CHUNK), axis=-1)
    idx = jnp.arange(CHUNK)
    causal = idx[:, None] >= idx[None, :]
    strict = idx[:, None] > idx[None, :]
    decay = jnp.exp(jnp.where(causal, gc[..., :, None] - gc[..., None, :], -jnp.inf))
    kb = k * beta[..., None]
    lower = jnp.where(strict, jnp.einsum('bhnid,bhnjd->bhnij', kb, k) * decay, 0.0)
    egc = jnp.exp(gc)[..., None]
    rhs = jnp.concatenate([v * beta[..., None], kb * egc], axis=-1)
    sol = lax.linalg.triangular_solve(lower, rhs, left_side=True, lower=True, unit_diagonal=True)
    u_base, w = sol[..., :Dv], sol[..., Dv:]
    attn = jnp.where(causal, jnp.einsum('bhnid,bhnjd->bhnij', q, k) * decay, 0.0)
    q_dec = q * egc
    g_last = gc[..., -1]
    k_dec = k * jnp.exp(g_last[..., None] - gc)[..., None]
    xs = (jnp.moveaxis(u_base, 2, 0), jnp.moveaxis(w, 2, 0), jnp.moveaxis(attn, 2, 0),
          jnp.moveaxis(q_dec, 2, 0), jnp.moveaxis(k_dec, 2, 0), jnp.moveaxis(jnp.exp(g_last), 2, 0))

    def step(S, inp):
        u_b, w_c, a_c, qd, kd, dl = inp
        u = u_b - jnp.einsum('bhck,bhkv->bhcv', w_c, S)
        o = jnp.einsum('bhck,bhkv->bhcv', qd, S) + jnp.einsum('bhij,bhjv->bhiv', a_c, u)
        S = S * dl[..., None, None] + jnp.einsum('bhck,bhcv->bhkv', kd, u)
        return S, o

    S0 = jnp.zeros((B_, H, Dk, Dv), jnp.float32)
    _, o = lax.scan(step, S0, xs)
    return jnp.moveaxis(o, 0, 2).reshape(B_, H, LP, Dv)


def hybrid_attention_mixer(h, w_in, fox_bf, conv_w, a_log, dt_bias, o_gain, w_out):
    B_, L, _ = h.shape
    f32 = jnp.float32
    fq, fk, fv, ff, gqkv, ga, gb, gz = split_cols(h @ w_in, HYB_SIZES)
    q_f = pad_seq(to_heads(fq, FOX_HEADS, FOX_DIM))
    k_f = pad_seq(to_heads(fk, FOX_HEADS, FOX_DIM))
    v_f = pad_seq(to_heads(fv, FOX_HEADS, FOX_DIM))
    log_f = pad_seq(jax.nn.log_sigmoid((ff + fox_bf).astype(f32)).transpose(0, 2, 1))
    o_fox = forgetting_attention(q_f, k_f, v_f, log_f)[:, :, PAD:]
    o_fox = o_fox.transpose(0, 2, 1, 3).reshape(B_, L, FOX_W)
    gqkv = jax.nn.silu(causal_depthwise_conv(gqkv, conv_w))
    gq, gk, gv = split_cols(gqkv, (GDN_QKW, GDN_QKW, GDN_VW))
    q_g = pad_seq(l2_normalize(to_heads(gq, GDN_HEADS, GDN_DK)))
    k_g = pad_seq(l2_normalize(to_heads(gk, GDN_HEADS, GDN_DK)))
    v_g = pad_seq(to_heads(gv, GDN_HEADS, GDN_DV))
    log_g = -jnp.exp(a_log.astype(f32)) * jax.nn.softplus((ga + dt_bias).astype(f32))
    log_g = pad_seq(log_g.transpose(0, 2, 1))
    beta = pad_seq(jax.nn.sigmoid(gb.astype(f32)).transpose(0, 2, 1))
    o_gdn = gated_delta_rule(q_g, k_g, v_g, log_g, beta)[:, :, PAD:].transpose(0, 2, 1, 3)
    o_gdn = rms_norm(o_gdn, o_gain) * jax.nn.silu(gz.reshape(B_, L, GDN_HEADS, GDN_DV).astype(f32))
    o = jnp.concatenate([o_fox, o_gdn.reshape(B_, L, GDN_VW)], axis=-1)
    return o @ w_out


def rwkv7_recurrence(r, decay, k, v, a, b):
    B_, L, H, N = r.shape
    xs = (jnp.moveaxis(r, 1, 0), jnp.moveaxis(decay, 1, 0), jnp.moveaxis(k, 1, 0),
          jnp.moveaxis(v, 1, 0), jnp.moveaxis(a, 1, 0), jnp.moveaxis(b, 1, 0))

    def step(S, inp):
        r_t, w_t, k_t, v_t, a_t, b_t = inp
        sa = jnp.einsum('bhvk,bhk->bhv', S, a_t)
        S = S * w_t[:, :, None, :] + sa[..., None] * b_t[:, :, None, :] + v_t[..., None] * k_t[:, :, None, :]
        return S, jnp.einsum('bhvk,bhk->bhv', S, r_t)

    S0 = jnp.zeros((B_, H, N, N), jnp.float32)
    _, y = lax.scan(step, S0, xs)
    return jnp.moveaxis(y, 0, 1)


def rwkv7_time_mix(h, mu, w_r, w_k, w_v, w0, w1, w2, a0, a1, a2, g1, g2, k_k, k_a, r_k, ln_w, ln_b, w_o):
    B_, L, D = h.shape
    H, N = RWKV_HEADS, RWKV_HEAD
    f32 = jnp.float32
    xx = jnp.pad(h, ((0, 0), (1, 0), (0, 0)))[:, :L] - h
    xr, xw, xk, xv, xa, xg = [h + xx * mu[i] for i in range(6)]
    r = xr @ w_r
    k = xk @ w_k
    v = xv @ w_v
    w_log = -jax.nn.softplus(-(w0 + jnp.tanh(xw @ w1) @ w2)) - 0.5
    a = jax.nn.sigmoid(a0 + (xa @ a1) @ a2)
    g = jax.nn.sigmoid(xg @ g1) @ g2
    kk = l2_normalize((k * k_k).reshape(B_, L, H, N))
    k = k * (1 + (a - 1) * k_a)
    r_h = r.reshape(B_, L, H, N).astype(f32)
    k_h = k.reshape(B_, L, H, N).astype(f32)
    v_h = v.reshape(B_, L, H, N).astype(f32)
    a_h = a.reshape(B_, L, H, N).astype(f32)
    decay = jnp.exp(-jnp.exp(w_log.reshape(B_, L, H, N).astype(f32)))
    y = rwkv7_recurrence(r_h, decay, k_h, v_h, -kk, kk * a_h)
    mean = jnp.mean(y, axis=-1, keepdims=True)
    var = jnp.mean(jnp.square(y - mean), axis=-1, keepdims=True)
    y = ((y - mean) * lax.rsqrt(var + RWKV_GN_EPS)).reshape(B_, L, D) * ln_w + ln_b
    bonus = jnp.sum(r_h * k_h * r_k.astype(f32), axis=-1, keepdims=True) * v_h
    return ((y + bonus.reshape(B_, L, D)) * g) @ w_o


def setup_inputs(seed: int = 0) -> dict:
    key = jax.random.key(seed)
    ks = iter(jax.random.split(key, 40))
    f32 = jnp.float32
    NE = (DEPTH + 1) // 2
    NO = DEPTH // 2

    def nrm(shape, scale):
        return jax.random.normal(next(ks), shape, f32) * scale

    def unif(shape, lo, hi):
        return jax.random.uniform(next(ks), shape, f32, minval=lo, maxval=hi)

    dt = jnp.exp(unif((NE, GDN_HEADS), math.log(1e-3), math.log(1e-1)))
    return {
        'x': nrm((BATCH, SEQ, D_MODEL), 1.0),
        'meta': nrm((N_META, D_MODEL), 1.0),
        'ffn_norm': 1.0 + nrm((DEPTH, 2, D_MODEL), 0.02),
        'ffn_w_in': nrm((DEPTH, 2, D_MODEL, 2 * D_FF), D_MODEL ** -0.5),
        'ffn_w_out': nrm((DEPTH, 2, D_FF, D_MODEL), D_FF ** -0.5),
        'mix_norm': 1.0 + nrm((DEPTH, D_MODEL), 0.02),
        'hyb_w_in': nrm((NE, D_MODEL, HYB_IN), D_MODEL ** -0.5),
        'hyb_fox_bf': 3.0 + nrm((NE, FOX_HEADS), 0.5),
        'hyb_conv': nrm((NE, GDN_CONV, GDN_QKV), GDN_CONV ** -0.5),
        'hyb_a_log': jnp.log(unif((NE, GDN_HEADS), 1.0, 16.0)),
        'hyb_dt_bias': dt + jnp.log(-jnp.expm1(-dt)),
        'hyb_o_gain': 1.0 + nrm((NE, GDN_DV), 0.02),
        'hyb_w_out': nrm((NE, MIX_W, D_MODEL), MIX_W ** -0.5),
        'rwkv_mu': unif((NO, 6, D_MODEL), 0.0, 1.0),
        'rwkv_w_r': nrm((NO, D_MODEL, D_MODEL), D_MODEL ** -0.5),
        'rwkv_w_k': nrm((NO, D_MODEL, D_MODEL), D_MODEL ** -0.5),
        'rwkv_w_v': nrm((NO, D_MODEL, D_MODEL), D_MODEL ** -0.5),
        'rwkv_w0': unif((NO, D_MODEL), -6.0, -1.0),
        'rwkv_w1': nrm((NO, D_MODEL, RWKV_DECAY_LORA), D_MODEL ** -0.5),
        'rwkv_w2': nrm((NO, RWKV_DECAY_LORA, D_MODEL), 0.1 * RWKV_DECAY_LORA ** -0.5),
        'rwkv_a0': nrm((NO, D_MODEL), 0.1),
        'rwkv_a1': nrm((NO, D_MODEL, RWKV_A_LORA), D_MODEL ** -0.5),
        'rwkv_a2': nrm((NO, RWKV_A_LORA, D_MODEL), 0.1 * RWKV_A_LORA ** -0.5),
        'rwkv_g1': nrm((NO, D_MODEL, RWKV_GATE_LORA), D_MODEL ** -0.5),
        'rwkv_g2': nrm((NO, RWKV_GATE_LORA, D_MODEL), RWKV_GATE_LORA ** -0.5),
        'rwkv_k_k': 0.85 + nrm((NO, D_MODEL), 0.02),
        'rwkv_k_a': 1.0 + nrm((NO, D_MODEL), 0.02),
        'rwkv_r_k': nrm((NO, RWKV_HEADS, RWKV_HEAD), 0.1),
        'rwkv_ln_w': 1.0 + nrm((NO, D_MODEL), 0.02),
        'rwkv_ln_b': nrm((NO, D_MODEL), 0.02),
        'rwkv_w_o': nrm((NO, D_MODEL, D_MODEL), D_MODEL ** -0.5),
        'final_norm': 1.0 + nrm((D_MODEL,), 0.02),
    }


def reference(x, meta, ffn_norm, ffn_w_in, ffn_w_out, mix_norm, hyb_w_in, hyb_fox_bf, hyb_conv,
              hyb_a_log, hyb_dt_bias, hyb_o_gain, hyb_w_out, rwkv_mu, rwkv_w_r, rwkv_w_k, rwkv_w_v,
              rwkv_w0, rwkv_w1, rwkv_w2, rwkv_a0, rwkv_a1, rwkv_a2, rwkv_g1, rwkv_g2, rwkv_k_k,
              rwkv_k_a, rwkv_r_k, rwkv_ln_w, rwkv_ln_b, rwkv_w_o, final_norm):
    B_ = x.shape[0]
    h = jnp.concatenate([jnp.broadcast_to(meta[None], (B_, N_META, D_MODEL)).astype(x.dtype), x], axis=1)
    for layer in range(DEPTH):
        j = layer // 2
        h = h + 0.5 * swiglu_ffn(rms_norm(h, ffn_norm[layer, 0]), ffn_w_in[layer, 0], ffn_w_out[layer, 0])
        hn = rms_norm(h, mix_norm[layer])
        if layer % 2 == 0:
            h = h + hybrid_attention_mixer(hn, hyb_w_in[j], hyb_fox_bf[j], hyb_conv[j], hyb_a_log[j],
                                           hyb_dt_bias[j], hyb_o_gain[j], hyb_w_out[j])
        else:
            h = h + rwkv7_time_mix(hn, rwkv_mu[j], rwkv_w_r[j], rwkv_w_k[j], rwkv_w_v[j], rwkv_w0[j],
                                   rwkv_w1[j], rwkv_w2[j], rwkv_a0[j], rwkv_a1[j], rwkv_a2[j],
                                   rwkv_g1[j], rwkv_g2[j], rwkv_k_k[j], rwkv_k_a[j], rwkv_r_k[j],
                                   rwkv_ln_w[j], rwkv_ln_b[j], rwkv_w_o[j])
        h = h + 0.5 * swiglu_ffn(rms_norm(h, ffn_norm[layer, 1]), ffn_w_in[layer, 1], ffn_w_out[layer, 1])
    return rms_norm(h, final_norm)[:, N_META:]
```

```cpp
#include <hip/hip_runtime.h>
#include <hip/hip_cooperative_groups.h>
#include <stdint.h>
#include <stdio.h>
namespace cg = cooperative_groups;

#ifndef MEGA
#define MEGA 1
#endif

typedef unsigned short bf16_t;
using bf16x8 = __attribute__((ext_vector_type(8))) short;
using f32x4 = __attribute__((ext_vector_type(4))) float;

constexpr int NB = 4;
constexpr int SEQ = 8192;
constexpr int NMETA = 16;
constexpr int PADR = 112;
constexpr int LP = 8320;
constexpr int R = NB * LP;
constexpr int D = 1024;
constexpr int DFF = 2816;
constexpr int MT = R / 128;
constexpr float EPS = 1e-6f;

constexpr int ZLD = 3584;
constexpr int HYB_NP = 3712;
constexpr int RK_NP = 3456;
constexpr int RKLD = 3072;
constexpr int MIDLD = 320;

constexpr size_t OFF_H = 0;
constexpr size_t SZ_H = (size_t)R * D * 4;
constexpr size_t OFF_WB = OFF_H + SZ_H;
constexpr size_t SZ_WB = (size_t)52 << 20;
constexpr size_t OFF_BIG = OFF_WB + SZ_WB;
constexpr size_t SZ_BIG = (size_t)R * ZLD * 2;
constexpr size_t OFF_ZG = OFF_BIG + SZ_BIG;
constexpr size_t SZ_ZG = (size_t)R * 16 * 4;
constexpr size_t OFF_CF = OFF_ZG + SZ_ZG;
constexpr size_t SZ_CF = (size_t)NB * 8 * LP * 4;
constexpr size_t OFF_GG = OFF_CF + SZ_CF;
constexpr size_t SZ_GG = (size_t)R * 8 * 4;
constexpr size_t OFF_O = OFF_GG + SZ_GG;
constexpr size_t SZ_O = (size_t)R * D * 2;
constexpr size_t WS_END = OFF_O + SZ_O;
constexpr size_t OFF_VT = WS_END;
constexpr size_t SZ_VT = (size_t)NB * 8 * 64 * LP * 2;
constexpr size_t OFF_BAR = OFF_VT + SZ_VT;
constexpr size_t OFF_STAT = OFF_BAR + 16384;
constexpr size_t OFF_CUCNT = OFF_STAT + 256;
constexpr size_t OFF_NPRIM = OFF_CUCNT + 16384;
constexpr size_t OFF_RANK = OFF_NPRIM + 256;
constexpr size_t SZ_SYNC = 16384 + 256 + 16384 + 256 + 4096;
static_assert(OFF_BAR + SZ_SYNC <= ((size_t)512 << 20), "ws overflow");
constexpr size_t OFF_RKV = OFF_BIG;
constexpr size_t OFF_MID = OFF_BIG + (size_t)R * RKLD * 2;
constexpr size_t OFF_MU = OFF_MID + (size_t)R * MIDLD * 2;
static_assert(OFF_MU + (size_t)R * 64 * 4 <= OFF_ZG, "mu overflow");

constexpr size_t W0_FIN_A = 0;
constexpr size_t W0_FOUT_A = W0_FIN_A + (size_t)5632 * 1024;
constexpr size_t W0_FIN_B = W0_FOUT_A + (size_t)1024 * 2816;
constexpr size_t W0_FOUT_B = W0_FIN_B + (size_t)5632 * 1024;
constexpr size_t W0_HIN = W0_FOUT_B + (size_t)1024 * 2816;
constexpr size_t W0_HOUT = W0_HIN + (size_t)HYB_NP * 1024;
constexpr size_t W0_END = W0_HOUT + (size_t)1024 * 1024;
static_assert(W0_END * 2 <= SZ_WB, "w0");
constexpr size_t W1_FIN_A = 0;
constexpr size_t W1_FOUT_A = W1_FIN_A + (size_t)5632 * 1024;
constexpr size_t W1_FIN_B = W1_FOUT_A + (size_t)1024 * 2816;
constexpr size_t W1_FOUT_B = W1_FIN_B + (size_t)5632 * 1024;
constexpr size_t W1_G1 = W1_FOUT_B + (size_t)1024 * 2816;
constexpr size_t W1_W2 = W1_G1 + (size_t)RK_NP * 2048;
constexpr size_t W1_A2 = W1_W2 + (size_t)1024 * 64;
constexpr size_t W1_G2 = W1_A2 + (size_t)1024 * 64;
constexpr size_t W1_WO = W1_G2 + (size_t)1024 * 192;
constexpr size_t W1_END = W1_WO + (size_t)1024 * 1024;
constexpr size_t OUT_W1M = (size_t)R * 1536 * 2;
static_assert(OUT_W1M + (W1_END - W1_G1) * 2 <= (size_t)NB * SEQ * D * 4, "d_out overflow");
static_assert(W1_END * 2 <= SZ_WB, "w1");

struct Params {
  const float *x, *meta, *ffn_norm, *ffn_w_in, *ffn_w_out, *mix_norm, *hyb_w_in, *hyb_fox_bf, *hyb_conv,
      *hyb_a_log, *hyb_dt_bias, *hyb_o_gain, *hyb_w_out, *rwkv_mu, *w_r, *w_k, *w_v, *w0, *w1, *w2, *a0, *a1, *a2,
      *g1, *g2, *k_k, *k_a, *r_k, *ln_w, *ln_b, *w_o, *final_norm;
  float* out;
  char* ws;
};

typedef float f32x2_t __attribute__((ext_vector_type(2)));
typedef __bf16 bf16x2_t __attribute__((ext_vector_type(2)));
__device__ __forceinline__ bf16_t f2bf(float f) {
  const __bf16 h = (__bf16)f;
  return __builtin_bit_cast(unsigned short, h);
}
__device__ __forceinline__ float bf2f(bf16_t h) { return __uint_as_float(((unsigned)h) << 16); }
__device__ __forceinline__ unsigned pack2(float a, float b) {
  const f32x2_t v = {a, b};
  const bf16x2_t r = __builtin_convertvector(v, bf16x2_t);
  return __builtin_bit_cast(unsigned, r);
}
__device__ __forceinline__ float wave_sum(float v) {
#pragma unroll
  for (int o = 32; o > 0; o >>= 1) v += __shfl_xor(v, o);
  return v;
}
__device__ __forceinline__ float sigmoidf_(float x) { return __builtin_amdgcn_rcpf(1.f + __expf(-x)); }
__device__ __forceinline__ float siluf_(float x) { return x * __builtin_amdgcn_rcpf(1.f + __expf(-x)); }
__device__ __forceinline__ float softplusf_(float x) { return x > 20.f ? x : __logf(1.f + __expf(x)); }
__device__ __forceinline__ float softplus_acc(float x) { return x > 20.f ? x : log1pf(__expf(x)); }

__device__ __forceinline__ float dpp_sum16(float v) {
  v += __int_as_float(__builtin_amdgcn_update_dpp(0, __float_as_int(v), 0xB1, 0xf, 0xf, true));
  v += __int_as_float(__builtin_amdgcn_update_dpp(0, __float_as_int(v), 0x4E, 0xf, 0xf, true));
  v += __int_as_float(__builtin_amdgcn_update_dpp(0, __float_as_int(v), 0x141, 0xf, 0xf, true));
  v += __int_as_float(__builtin_amdgcn_update_dpp(0, __float_as_int(v), 0x140, 0xf, 0xf, true));
  return v;
}
__device__ __forceinline__ float wave_sum_fast(float v) {
  v = dpp_sum16(v);
  const int vi = __float_as_int(v);
  return __int_as_float(__builtin_amdgcn_readlane(vi, 0)) + __int_as_float(__builtin_amdgcn_readlane(vi, 16)) +
         __int_as_float(__builtin_amdgcn_readlane(vi, 32)) + __int_as_float(__builtin_amdgcn_readlane(vi, 48));
}
__device__ __forceinline__ float dpp_sum8(float v) {
  v += __int_as_float(__builtin_amdgcn_update_dpp(0, __float_as_int(v), 0xB1, 0xf, 0xf, true));
  v += __int_as_float(__builtin_amdgcn_update_dpp(0, __float_as_int(v), 0x4E, 0xf, 0xf, true));
  v += __int_as_float(__builtin_amdgcn_update_dpp(0, __float_as_int(v), 0x141, 0xf, 0xf, true));
  return v;
}
__device__ __forceinline__ float logsigf_(float x) { return fminf(x, 0.f) - log1pf(__expf(-fabsf(x))); }
__device__ __forceinline__ int otid() { int t = threadIdx.x; asm volatile("" : "+v"(t)); return t; }

struct WJob {
  const float* src; bf16_t* dst; const float* mu;
  int srcld, srccol0, ncols, nrows, r0, dstld, dstk0, ksrc, kjob, perm, smode;
};

__device__ __forceinline__ void wjob_run(const float* jsrc, bf16_t* jdst, int jsrcld, int jsrccol0, int jncols, int jnrows, int jr0,
                                      int jdstld, int jdstk0, int jksrc, int jkjob, int jperm, int jsmode, const float* jmu,
                                      float* tile  , int bid, int nb) {
  WJob j; j.src = jsrc; j.dst = jdst; j.mu = jmu; j.srcld = jsrcld; j.srccol0 = jsrccol0; j.ncols = jncols; j.nrows = jnrows;
  j.r0 = jr0; j.dstld = jdstld; j.dstk0 = jdstk0; j.ksrc = jksrc; j.kjob = jkjob; j.perm = jperm; j.smode = jsmode;
  const int tid = otid();
  const int tn = (j.nrows + 31) >> 5, tk = j.kjob >> 5;
  for (int t = bid; t < tn * tk; t += nb) {
    const int n0 = (t / tk) * 32, k0 = (t % tk) * 32;
    {
      const int tx = tid & 31, ty = tid >> 5;
      const int n = n0 + tx;
      int sc = -1;
      if (n < j.ncols) {
        if (j.perm) { int q = n >> 5, i = n & 31; sc = (i < 16) ? (q * 16 + i) : (DFF + q * 16 + i - 16); }
        else sc = j.srccol0 + n;
      }
#pragma unroll
      for (int i = 0; i < 4; i++) {
        const int k = k0 + ty + 8 * i;
        float v = 0.f;
        if (sc >= 0 && k < j.ksrc) {
          v = j.src[(size_t)k * j.srcld + sc];
          if (j.smode == 1) v *= j.mu[k]; else if (j.smode == 2) v *= (1.f - j.mu[k]);
        }
        tile[(ty + 8 * i) * 33 + tx] = v;
      }
    }
    __syncthreads();
    {
      const int kx = tid & 31, ny = tid >> 5;
#pragma unroll
      for (int i = 0; i < 4; i++) {
        const int n = n0 + ny + 8 * i;
        if (n < j.nrows) j.dst[(size_t)(j.r0 + n) * j.dstld + j.dstk0 + k0 + kx] = f2bf(tile[kx * 33 + ny + 8 * i]);
      }
    }
    __syncthreads();
  }
}

__device__ __forceinline__ WJob mkjob(const float* src, bf16_t* dst, int srcld, int srccol0, int ncols, int nrows, int r0,
                                      int dstld, int dstk0, int ksrc, int kjob, int perm, int smode, const float* mu) {
  WJob j; j.src = src; j.dst = dst; j.mu = mu; j.srcld = srcld; j.srccol0 = srccol0; j.ncols = ncols; j.nrows = nrows;
  j.r0 = r0; j.dstld = dstld; j.dstk0 = dstk0; j.ksrc = ksrc; j.kjob = kjob; j.perm = perm; j.smode = smode; return j;
}

__device__ __forceinline__ void prep_weights(const Params& p, int layer, int which, float* tile, int bid, int nb) {
  bf16_t* wb = (bf16_t*)(p.ws + OFF_WB);
  for (int s = 0; s < 2; s++) {
    if (!((which >> s) & 1)) continue;
    const float* win = p.ffn_w_in + (size_t)(layer * 2 + s) * 1024 * 5632;
    const float* wout = p.ffn_w_out + (size_t)(layer * 2 + s) * 2816 * 1024;
    bf16_t* din = wb + (s ? W0_FIN_B : W0_FIN_A);
    bf16_t* dout = wb + (s ? W0_FOUT_B : W0_FOUT_A);
    wjob_run(win, din, 5632, 0, 5632, 5632, 0, 1024, 0, 1024, 1024, 1, 0, nullptr, tile, bid, nb);
    wjob_run(wout, dout, 1024, 0, 1024, 1024, 0, 2816, 0, 2816, 2816, 0, 0, nullptr, tile, bid, nb);
  }
  if (!(which & 4)) return;
  if (layer == 0) {
    bf16_t* d = wb + W0_HIN;
    const float* s = p.hyb_w_in;
    wjob_run(s, d, 3600, 0, 1536, 1536, 0, 1024, 0, 1024, 1024, 0, 0, nullptr, tile, bid, nb);
    wjob_run(s, d, 3600, 1544, 1536, 1536, 1536, 1024, 0, 1024, 1024, 0, 0, nullptr, tile, bid, nb);
    wjob_run(s, d, 3600, 3088, 512, 512, 3072, 1024, 0, 1024, 1024, 0, 0, nullptr, tile, bid, nb);
    wjob_run(s, d, 3600, 1536, 8, 8, 3584, 1024, 0, 1024, 1024, 0, 0, nullptr, tile, bid, nb);
    wjob_run(s, d, 3600, 3080, 8, 120, 3592, 1024, 0, 1024, 1024, 0, 0, nullptr, tile, bid, nb);
    wjob_run(p.hyb_w_out, wb + W0_HOUT, 1024, 0, 1024, 1024, 0, 1024, 0, 1024, 1024, 0, 0, nullptr, tile, bid, nb);
  } else {
    bf16_t* wm = (bf16_t*)((char*)p.out + OUT_W1M) - W1_G1;
    bf16_t* d = wm + W1_G1;
    const float* mu = p.rwkv_mu;
    for (int half = 0; half < 2; half++) {
      const int sm = half ? 1 : 2;
      const int k0 = half * 1024;
      wjob_run(p.w_r, d, 1024, 0, 1024, 1024, 0, 2048, k0, 1024, 1024, 0, sm, mu + 0 * 1024, tile, bid, nb);
      wjob_run(p.w_k, d, 1024, 0, 1024, 1024, 1024, 2048, k0, 1024, 1024, 0, sm, mu + 2 * 1024, tile, bid, nb);
      wjob_run(p.w_v, d, 1024, 0, 1024, 1024, 2048, 2048, k0, 1024, 1024, 0, sm, mu + 3 * 1024, tile, bid, nb);
      wjob_run(p.w1, d, 64, 0, 64, 64, 3072, 2048, k0, 1024, 1024, 0, sm, mu + 1 * 1024, tile, bid, nb);
      wjob_run(p.a1, d, 64, 0, 64, 64, 3136, 2048, k0, 1024, 1024, 0, sm, mu + 4 * 1024, tile, bid, nb);
      wjob_run(p.g1, d, 160, 0, 160, 256, 3200, 2048, k0, 1024, 1024, 0, sm, mu + 5 * 1024, tile, bid, nb);
    }
    wjob_run(p.w2, wm + W1_W2, 1024, 0, 1024, 1024, 0, 64, 0, 64, 64, 0, 0, nullptr, tile, bid, nb);
    wjob_run(p.a2, wm + W1_A2, 1024, 0, 1024, 1024, 0, 64, 0, 64, 64, 0, 0, nullptr, tile, bid, nb);
    wjob_run(p.g2, wm + W1_G2, 1024, 0, 1024, 1024, 0, 192, 0, 160, 192, 0, 0, nullptr, tile, bid, nb);
    wjob_run(p.w_o, wm + W1_WO, 1024, 0, 1024, 1024, 0, 1024, 0, 1024, 1024, 0, 0, nullptr, tile, bid, nb);
  }
}

template <int MODE>
__device__ __forceinline__ void norm_phase(const Params& p, const float* gain, bf16_t* hn  , int bid, int nb) {
  float* H = (float*)(p.ws + OFF_H);
  const int tid_ = otid(); const int lane = tid_ & 63, wave = tid_ >> 6;
  if (bid == 0) {
    for (int i = threadIdx.x; i < D; i += 256) hn[-D + i] = 0;
  }
  if (MODE == 0) {
    const float4 gq0 = *(const float4*)(gain + lane * 4), gq1 = *(const float4*)(gain + 256 + lane * 4);
    const float4 gq2 = *(const float4*)(gain + 512 + lane * 4), gq3 = *(const float4*)(gain + 768 + lane * 4);
    for (int row = bid * 4 + wave; row < R; row += nb * 8) {
      const int row2 = row + nb * 4;
      const bool has2 = row2 < R;
      const int r2 = has2 ? row2 : row;
      float4 va[4], vb[4];
#pragma unroll
      for (int i = 0; i < 4; i++) {
        va[i] = *(const float4*)(H + (size_t)row * D + i * 256 + lane * 4);
        vb[i] = *(const float4*)(H + (size_t)r2 * D + i * 256 + lane * 4);
      }
      float sa = 0.f, sb = 0.f;
#pragma unroll
      for (int i = 0; i < 4; i++) {
        sa += va[i].x * va[i].x + va[i].y * va[i].y + va[i].z * va[i].z + va[i].w * va[i].w;
        sb += vb[i].x * vb[i].x + vb[i].y * vb[i].y + vb[i].z * vb[i].z + vb[i].w * vb[i].w;
      }
      const float ca = rsqrtf(wave_sum_fast(sa) * (1.f / D) + EPS), cb = rsqrtf(wave_sum_fast(sb) * (1.f / D) + EPS);
      const float4 gq[4] = {gq0, gq1, gq2, gq3};
#pragma unroll
      for (int i = 0; i < 4; i++) {
        uint2 o;
        o.x = pack2(va[i].x * ca * gq[i].x, va[i].y * ca * gq[i].y);
        o.y = pack2(va[i].z * ca * gq[i].z, va[i].w * ca * gq[i].w);
        *(uint2*)(hn + (size_t)row * D + i * 256 + lane * 4) = o;
        if (has2) {
          o.x = pack2(vb[i].x * cb * gq[i].x, vb[i].y * cb * gq[i].y);
          o.y = pack2(vb[i].z * cb * gq[i].z, vb[i].w * cb * gq[i].w);
          *(uint2*)(hn + (size_t)row2 * D + i * 256 + lane * 4) = o;
        }
      }
    }
    return;
  }
  for (int row = bid * 4 + wave; row < R; row += nb * 4) {
    const int b = row / LP, pr = row - b * LP;
    float4 v[4];
    if (MODE == 1) {
      const float* src = nullptr;
      if (pr >= 128) src = p.x + ((size_t)b * SEQ + (pr - 128)) * D;
      else if (pr >= PADR) src = p.meta + (size_t)(pr - PADR) * D;
#pragma unroll
      for (int i = 0; i < 4; i++) {
        v[i] = src ? *(const float4*)(src + i * 256 + lane * 4) : make_float4(0.f, 0.f, 0.f, 0.f);
        *(float4*)(H + (size_t)row * D + i * 256 + lane * 4) = v[i];
      }
    } else {
#pragma unroll
      for (int i = 0; i < 4; i++) v[i] = *(const float4*)(H + (size_t)row * D + i * 256 + lane * 4);
    }
    float ss = 0.f;
#pragma unroll
    for (int i = 0; i < 4; i++) ss += v[i].x * v[i].x + v[i].y * v[i].y + v[i].z * v[i].z + v[i].w * v[i].w;
    ss = wave_sum(ss);
    const float sc = rsqrtf(ss * (1.f / D) + EPS);
#pragma unroll
    for (int i = 0; i < 4; i++) {
      const float4 g = *(const float4*)(gain + i * 256 + lane * 4);
      uint2 o;
      o.x = pack2(v[i].x * sc * g.x, v[i].y * sc * g.y);
      o.y = pack2(v[i].z * sc * g.z, v[i].w * sc * g.w);
      *(uint2*)(hn + (size_t)row * D + i * 256 + lane * 4) = o;
    }
  }
}

__device__ __forceinline__ void final_phase(const Params& p, int bid, int nb) {
  const float* H = (const float*)(p.ws + OFF_H);
  const int tid_ = otid(); const int lane = tid_ & 63, wave = tid_ >> 6;
  float4 g[4];
#pragma unroll
  for (int i = 0; i < 4; i++) g[i] = *(const float4*)(p.final_norm + i * 256 + lane * 4);
  for (int t = bid * 4 + wave; t < NB * SEQ; t += nb * 8) {
    const int t2r = t + nb * 4;
    const bool has2 = t2r < NB * SEQ;
    const int t2 = has2 ? t2r : t;
    const size_t ra = (size_t)(t / SEQ) * LP + 128 + (t % SEQ), rb = (size_t)(t2 / SEQ) * LP + 128 + (t2 % SEQ);
    float4 va[4], vb[4];
#pragma unroll
    for (int i = 0; i < 4; i++) {
      va[i] = *(const float4*)(H + ra * D + i * 256 + lane * 4);
      vb[i] = *(const float4*)(H + rb * D + i * 256 + lane * 4);
    }
    float sa = 0.f, sb = 0.f;
#pragma unroll
    for (int i = 0; i < 4; i++) {
      sa += va[i].x * va[i].x + va[i].y * va[i].y + va[i].z * va[i].z + va[i].w * va[i].w;
      sb += vb[i].x * vb[i].x + vb[i].y * vb[i].y + vb[i].z * vb[i].z + vb[i].w * vb[i].w;
    }
    const float ca = rsqrtf(wave_sum_fast(sa) * (1.f / D) + EPS), cb = rsqrtf(wave_sum_fast(sb) * (1.f / D) + EPS);
#pragma unroll
    for (int i = 0; i < 4; i++) {
      *(float4*)(p.out + (size_t)t * D + i * 256 + lane * 4) =
          make_float4(va[i].x * ca * g[i].x, va[i].y * ca * g[i].y, va[i].z * ca * g[i].z, va[i].w * ca * g[i].w);
      if (has2)
        *(float4*)(p.out + (size_t)t2 * D + i * 256 + lane * 4) =
            make_float4(vb[i].x * cb * g[i].x, vb[i].y * cb * g[i].y, vb[i].z * cb * g[i].z, vb[i].w * cb * g[i].w);
    }
  }
}

__device__ __forceinline__ float xrow16_sum(float x) {
  auto s = __builtin_amdgcn_permlane16_swap(__float_as_uint(x), __float_as_uint(x), false, false);
  x = __uint_as_float(s[0]) + __uint_as_float(s[1]);
  auto t = __builtin_amdgcn_permlane32_swap(__float_as_uint(x), __float_as_uint(x), false, false);
  return __uint_as_float(t[0]) + __uint_as_float(t[1]);
}

enum { EPI_SWIGLU = 0, EPI_RESID = 1, EPI_HYB = 2, EPI_RK1 = 3, EPI_LW = 4, EPI_LA = 5, EPI_LG = 6 };
struct Epi {
  float* f0; bf16_t* b0; bf16_t* b1; const float* v0; const bf16_t* c0; float alpha;
  const bf16_t* y01; const bf16_t* y23; const float* mu; const float* sbp; const float* lnw; const float* lnb;
};

template <int EPI, bool SHIFT, int BM = 128>
__device__ __forceinline__ void gemm_phase(const bf16_t* __restrict__ A, int lda, const bf16_t* __restrict__ Wt, int K, int ntn,
                           const Epi e, bf16_t* smem, int bid, int nb, int tbeg = 0, int tend = 1 << 30) {
  const int tid = otid(), lane = tid & 63, wave = tid >> 6;
  const int wm = wave >> 1, wn = wave & 1;
  const int KT = K >> 6;
  const int lrow = tid >> 3, lchunk = tid & 7;
  const int lsw = ((lchunk ^ ((lrow >> 1) & 7)) << 3);
  const int fr = lane & 15, fq = lane >> 4;
  const int fsw = (fr >> 1) & 7;
  constexpr bool TR = true;
  constexpr int MI = BM / 32;
  constexpr int MTX = R / BM;
  constexpr int MREM = MTX % 8;
  const int band = 8 * ntn, nfull = (MTX / 8) * band;
  for (int it = 0;; it++) {
    int tile;
    if (nb == 512 && tend - tbeg > nb) tile = ((it * 8 + (bid & 7)) << 6) + (bid >> 3); else tile = it * nb + bid;
    tile += tbeg;
    if (tile >= MTX * ntn || tile >= tend) break;
    int mt, nt;
    if (tile < nfull) { const int b_ = tile / band, w_ = tile - b_ * band; nt = w_ >> 3; mt = b_ * 8 + (w_ & 7); }
    else { const int w_ = tile - nfull; nt = w_ / MREM; mt = (MTX / 8) * 8 + (w_ - nt * MREM); }
    const int m0 = mt * BM, n0 = nt * 128;
    f32x4 acc[MI][4];
#pragma unroll
    for (int i = 0; i < MI; i++)
#pragma unroll
      for (int j = 0; j < 4; j++) acc[i][j] = (f32x4){0.f, 0.f, 0.f, 0.f};
    if constexpr (BM == 128) {
    const bf16_t* ap = A + (size_t)(m0 + lrow) * lda + lsw;
    const bf16_t* bp = Wt + (size_t)(n0 + lrow) * K + lsw;
    const size_t a32 = (size_t)32 * lda, b32 = (size_t)32 * K;
    typedef __attribute__((address_space(3))) unsigned lds_u32;
    lds_u32* sbase = (lds_u32*)(smem) + wave * 256;
#define GLDS(AP, KC, KW, OFF)                                                                                   \
  __builtin_amdgcn_global_load_lds((const unsigned*)((AP) + (KC)), sbase + (OFF) / 2, 16, 0, 0);               \
  __builtin_amdgcn_global_load_lds((const unsigned*)((AP) + a32 + (KC)), sbase + ((OFF) + 2048) / 2, 16, 0, 0);   \
  __builtin_amdgcn_global_load_lds((const unsigned*)((AP) + 2 * a32 + (KC)), sbase + ((OFF) + 4096) / 2, 16, 0, 0); \
  __builtin_amdgcn_global_load_lds((const unsigned*)((AP) + 3 * a32 + (KC)), sbase + ((OFF) + 6144) / 2, 16, 0, 0); \
  __builtin_amdgcn_global_load_lds((const unsigned*)(bp + (KW)), sbase + ((OFF) + 8192) / 2, 16, 0, 0);           \
  __builtin_amdgcn_global_load_lds((const unsigned*)(bp + b32 + (KW)), sbase + ((OFF) + 8192 + 2048) / 2, 16, 0, 0); \
  __builtin_amdgcn_global_load_lds((const unsigned*)(bp + 2 * b32 + (KW)), sbase + ((OFF) + 8192 + 4096) / 2, 16, 0, 0); \
  __builtin_amdgcn_global_load_lds((const unsigned*)(bp + 3 * b32 + (KW)), sbase + ((OFF) + 8192 + 6144) / 2, 16, 0, 0);
    GLDS(ap, 0, 0, 0)
    asm volatile("s_waitcnt vmcnt(0)" ::: "memory");
    __syncthreads();
    for (int kt = 0; kt < KT; kt++) {
      const int cur = (kt & 1) * 16384;
      if (kt + 1 < KT) {
        const bf16_t* apx = ap;
        int kc = (kt + 1) * 64;
        if (SHIFT && kc >= 1024) { apx = ap - lda; kc -= 1024; }
        const int nxt = ((kt + 1) & 1) * 16384;
        GLDS(apx, kc, (kt + 1) * 64, nxt)
      }
#pragma unroll
      for (int kk = 0; kk < 2; kk++) {
        bf16x8 af[4], bfr[4];
        const int csw = (((kk * 4 + fq) ^ fsw) << 3);
#pragma unroll
        for (int mi = 0; mi < 4; mi++) af[mi] = *(const bf16x8*)(smem + cur + (wm * 64 + mi * 16 + fr) * 64 + csw);
#pragma unroll
        for (int ni = 0; ni < 4; ni++) bfr[ni] = *(const bf16x8*)(smem + cur + 8192 + (wn * 64 + ni * 16 + fr) * 64 + csw);
#pragma unroll
        for (int mi = 0; mi < 4; mi++)
#pragma unroll
          for (int ni = 0; ni < 4; ni++)
            acc[mi][ni] = TR ? __builtin_amdgcn_mfma_f32_16x16x32_bf16(bfr[ni], af[mi], acc[mi][ni], 0, 0, 0)
                             : __builtin_amdgcn_mfma_f32_16x16x32_bf16(af[mi], bfr[ni], acc[mi][ni], 0, 0, 0);
      }
      asm volatile("s_waitcnt vmcnt(0)" ::: "memory");
      __syncthreads();
    }
#undef GLDS
    } else {
      const bf16_t* ap = A + (size_t)(m0 + lrow) * lda + lsw;
      const bf16_t* bp = Wt + (size_t)(n0 + lrow) * K + lsw;
      const size_t a32 = (size_t)32 * lda, b32 = (size_t)32 * K;
      typedef __attribute__((address_space(3))) unsigned lds_u32;
      lds_u32* sbase = (lds_u32*)(smem) + wave * 256;
      for (int kt = 0; kt < KT; kt++) {
        {
          const bf16_t* apx = ap;
          int kc = kt * 64;
          if (SHIFT && kc >= 1024) { apx = ap - lda; kc -= 1024; }
#pragma unroll
          for (int i = 0; i < 8; i++)
            __builtin_amdgcn_global_load_lds((const unsigned*)(apx + i * a32 + kc), sbase + i * 1024, 16, 0, 0);
#pragma unroll
          for (int i = 0; i < 4; i++)
            __builtin_amdgcn_global_load_lds((const unsigned*)(bp + i * b32 + kt * 64), sbase + 8192 + i * 1024, 16, 0, 0);
        }
        asm volatile("s_waitcnt vmcnt(0)" ::: "memory");
        __syncthreads();
#pragma unroll
        for (int kk = 0; kk < 2; kk++) {
          bf16x8 af[MI], bfr[4];
          const int csw = (((kk * 4 + fq) ^ fsw) << 3);
#pragma unroll
          for (int mi = 0; mi < MI; mi++) af[mi] = *(const bf16x8*)(smem + (wm * 128 + mi * 16 + fr) * 64 + csw);
#pragma unroll
          for (int ni = 0; ni < 4; ni++) bfr[ni] = *(const bf16x8*)(smem + 16384 + (wn * 64 + ni * 16 + fr) * 64 + csw);
#pragma unroll
          for (int mi = 0; mi < MI; mi++)
#pragma unroll
            for (int ni = 0; ni < 4; ni++)
              acc[mi][ni] = __builtin_amdgcn_mfma_f32_16x16x32_bf16(bfr[ni], af[mi], acc[mi][ni], 0, 0, 0);
        }
        __syncthreads();
      }
    }
    if constexpr (!TR) {
    const unsigned rbase = (unsigned)(m0 + wm * 64 + fq * 4);
    const unsigned cbase = (unsigned)(n0 + wn * 64 + fr);
#pragma unroll
    for (int mi = 0; mi < 4; mi++) {
#pragma unroll
      for (int j = 0; j < 4; j++) {
        const unsigned row = rbase + mi * 16 + j;
        if constexpr (EPI == EPI_SWIGLU) {
#pragma unroll
          for (int np = 0; np < 2; np++) {
            const unsigned hc = ((unsigned)(n0 + wn * 64) >> 1) + np * 16 + fr;
            const float g = acc[mi][2 * np][j], u = acc[mi][2 * np + 1][j];
            e.b0[row * (unsigned)DFF + hc] = f2bf(siluf_(g) * u);
          }
        } else {
          const unsigned pr = row % (unsigned)LP;
#pragma unroll
          for (int ni = 0; ni < 4; ni++) {
            const unsigned col = cbase + ni * 16;
            const float a = acc[mi][ni][j];
            if constexpr (EPI == EPI_RESID) {
              if (pr >= PADR) { float* hp = e.f0 + (row * (unsigned)D + col); *hp = *hp + e.alpha * a; }
            } else if constexpr (EPI == EPI_HYB) {
              if (col >= 1024 && col < 1536) {
                const unsigned bb = row / (unsigned)LP;
                e.b1[((bb * 8u + ((col - 1024) >> 6)) * 64u + (col & 63)) * (unsigned)LP + (row - bb * (unsigned)LP)] = f2bf(a);
              } else if (col < ZLD) e.b0[row * (unsigned)ZLD + col] = f2bf(a);
              else if (col < ZLD + 16) e.f0[row * 16u + (col - ZLD)] = a;
            } else if constexpr (EPI == EPI_RK1) {
              if (col < 3072) e.b0[row * (unsigned)RKLD + col] = f2bf(a);
              else if (col < 3136) e.b1[row * (unsigned)MIDLD + (col - 3072)] = f2bf(tanhf(a));
              else if (col < 3200) e.b1[row * (unsigned)MIDLD + (col - 3072)] = f2bf(a);
              else if (col < 3360) e.b1[row * (unsigned)MIDLD + (col - 3072)] = f2bf(sigmoidf_(a));
              else if (col < 3392) e.b1[row * (unsigned)MIDLD + (col - 3072)] = 0;
            } else if constexpr (EPI == EPI_LW) {
              const float wl = -softplusf_(-(e.v0[col] + a)) - 0.5f;
              e.b0[row * (unsigned)D + col] = f2bf(__expf(wl));
            } else if constexpr (EPI == EPI_LA) {
              e.b0[row * (unsigned)D + col] = f2bf(sigmoidf_(e.v0[col] + a));
            } else if constexpr (EPI == EPI_LG) {
              const float yv = bf2f(e.c0[row * (unsigned)RKLD + 2048 + col]);
              e.b0[row * (unsigned)D + col] = (pr >= PADR) ? f2bf(a * yv) : (bf16_t)0;
            }
          }
        }
        __builtin_amdgcn_sched_barrier(0);
      }
    }
    } else {
      const unsigned rb2 = (unsigned)(m0 + wm * (BM / 2) + fr);
      const unsigned cb2 = (unsigned)(n0 + wn * 64 + fq * 4);
#pragma unroll
      for (int mi = 0; mi < MI; mi++) {
        const unsigned row = rb2 + mi * 16;
        const unsigned pr = row % (unsigned)LP;
        if constexpr (EPI == EPI_LG) {
          const unsigned hh = (unsigned)(n0 + wn * 64) >> 6;
          const unsigned bb = row / (unsigned)LP;
          const bf16_t* yb = (bb < 2u) ? (e.y01 + (size_t)bb * LP * D) : (e.y23 + (size_t)(bb - 2u) * LP * D);
          float yv[4][4], vv[4][4];
          float s1 = 0.f;
#pragma unroll
          for (int ni = 0; ni < 4; ni++) {
            const unsigned col = cb2 + ni * 16;
            const uint2 yu = *(const uint2*)(yb + (size_t)pr * D + col);
            const uint2 vu = *(const uint2*)(e.c0 + (row * (unsigned)RKLD + 2048 + col));
            const float m_ = e.mu[row * 64u + hh * 4u + ni];
            yv[ni][0] = bf2f((bf16_t)(yu.x & 0xffff)) + m_; yv[ni][1] = bf2f((bf16_t)(yu.x >> 16)) + m_;
            yv[ni][2] = bf2f((bf16_t)(yu.y & 0xffff)) + m_; yv[ni][3] = bf2f((bf16_t)(yu.y >> 16)) + m_;
            vv[ni][0] = bf2f((bf16_t)(vu.x & 0xffff)); vv[ni][1] = bf2f((bf16_t)(vu.x >> 16));
            vv[ni][2] = bf2f((bf16_t)(vu.y & 0xffff)); vv[ni][3] = bf2f((bf16_t)(vu.y >> 16));
            s1 += (yv[ni][0] + yv[ni][1]) + (yv[ni][2] + yv[ni][3]);
          }
          const float mean = xrow16_sum(s1) * (1.f / 64.f);
          float s2 = 0.f;
#pragma unroll
          for (int ni = 0; ni < 4; ni++)
#pragma unroll
            for (int j = 0; j < 4; j++) { yv[ni][j] -= mean; s2 += yv[ni][j] * yv[ni][j]; }
          const float rstd = rsqrtf(xrow16_sum(s2) * (1.f / 64.f) + 64e-5f);
          const float sb = e.sbp[row * 16u + hh];
#pragma unroll
          for (int ni = 0; ni < 4; ni++) {
            const unsigned col = cb2 + ni * 16;
            const float4 lw = *(const float4*)(e.lnw + col), lb = *(const float4*)(e.lnb + col);
            const f32x4 a = acc[mi][ni];
            uint2 o;
            o.x = pack2(a[0] * (yv[ni][0] * rstd * lw.x + lb.x + sb * vv[ni][0]), a[1] * (yv[ni][1] * rstd * lw.y + lb.y + sb * vv[ni][1]));
            o.y = pack2(a[2] * (yv[ni][2] * rstd * lw.z + lb.z + sb * vv[ni][2]), a[3] * (yv[ni][3] * rstd * lw.w + lb.w + sb * vv[ni][3]));
            if (pr < PADR) { o.x = 0u; o.y = 0u; }
            *(uint2*)(e.b0 + (row * (unsigned)D + col)) = o;
          }
        } else if constexpr (EPI == EPI_SWIGLU) {
#pragma unroll
          for (int np = 0; np < 2; np++) {
            const unsigned hc = ((unsigned)(n0 + wn * 64) >> 1) + np * 16 + fq * 4;
            const f32x4 g = acc[mi][2 * np], u = acc[mi][2 * np + 1];
            uint2 o;
            o.x = pack2(siluf_(g[0]) * u[0], siluf_(g[1]) * u[1]);
            o.y = pack2(siluf_(g[2]) * u[2], siluf_(g[3]) * u[3]);
            *(uint2*)(e.b0 + (row * (unsigned)DFF + hc)) = o;
          }
        } else {
#pragma unroll
          for (int ni = 0; ni < 4; ni++) {
            const unsigned col = cb2 + ni * 16;
            const f32x4 a = acc[mi][ni];
            if constexpr (EPI == EPI_RESID) {
              if (pr >= PADR) {
                float4* hp = (float4*)(e.f0 + (row * (unsigned)D + col));
                float4 hv = *hp;
                hv.x += e.alpha * a[0]; hv.y += e.alpha * a[1]; hv.z += e.alpha * a[2]; hv.w += e.alpha * a[3];
                *hp = hv;
              }
            } else if constexpr (EPI == EPI_HYB) {
              if (col >= 1024 && col < 1536) {
                const unsigned bb = row / (unsigned)LP;
                const unsigned vb_ = ((bb * 8u + ((col - 1024) >> 6)) * 64u + (col & 63)) * (unsigned)LP + (row - bb * (unsigned)LP);
                e.b1[vb_] = f2bf(a[0]); e.b1[vb_ + LP] = f2bf(a[1]); e.b1[vb_ + 2 * LP] = f2bf(a[2]); e.b1[vb_ + 3 * LP] = f2bf(a[3]);
              } else if (col < ZLD) {
                uint2 o; o.x = pack2(a[0], a[1]); o.y = pack2(a[2], a[3]);
                *(uint2*)(e.b0 + (row * (unsigned)ZLD + col)) = o;
              } else if (col < ZLD + 16) {
                *(float4*)(e.f0 + (row * 16u + (col - ZLD))) = make_float4(a[0], a[1], a[2], a[3]);
              }
            } else if constexpr (EPI == EPI_RK1) {
              uint2 o;
              if (col < 3072) {
                o.x = pack2(a[0], a[1]); o.y = pack2(a[2], a[3]);
                *(uint2*)(e.b0 + (row * (unsigned)RKLD + col)) = o;
              } else if (col < 3392) {
                if (col < 3136) { o.x = pack2(tanhf(a[0]), tanhf(a[1])); o.y = pack2(tanhf(a[2]), tanhf(a[3])); }
                else if (col < 3200) { o.x = pack2(a[0], a[1]); o.y = pack2(a[2], a[3]); }
                else if (col < 3360) { o.x = pack2(sigmoidf_(a[0]), sigmoidf_(a[1])); o.y = pack2(sigmoidf_(a[2]), sigmoidf_(a[3])); }
                else { o.x = 0u; o.y = 0u; }
                *(uint2*)(e.b1 + (row * (unsigned)MIDLD + (col - 3072))) = o;
              }
            } else if constexpr (EPI == EPI_LW) {
              const float4 w0v = *(const float4*)(e.v0 + col);
              uint2 o;
              o.x = pack2(__expf(-softplusf_(-(w0v.x + a[0])) - 0.5f), __expf(-softplusf_(-(w0v.y + a[1])) - 0.5f));
              o.y = pack2(__expf(-softplusf_(-(w0v.z + a[2])) - 0.5f), __expf(-softplusf_(-(w0v.w + a[3])) - 0.5f));
              *(uint2*)(e.b0 + (row * (unsigned)D + col)) = o;
            } else if constexpr (EPI == EPI_LA) {
              const float4 a0v = *(const float4*)(e.v0 + col);
              uint2 o;
              o.x = pack2(sigmoidf_(a0v.x + a[0]), sigmoidf_(a0v.y + a[1]));
              o.y = pack2(sigmoidf_(a0v.z + a[2]), sigmoidf_(a0v.w + a[3]));
              *(uint2*)(e.b0 + (row * (unsigned)D + col)) = o;
            } else if constexpr (EPI == EPI_LG) {
              const uint2 yv = *(const uint2*)(e.c0 + (row * (unsigned)RKLD + 2048 + col));
              uint2 o;
              o.x = pack2(a[0] * bf2f((bf16_t)(yv.x & 0xffff)), a[1] * bf2f((bf16_t)(yv.x >> 16)));
              o.y = pack2(a[2] * bf2f((bf16_t)(yv.y & 0xffff)), a[3] * bf2f((bf16_t)(yv.y >> 16)));
              if (pr < PADR) { o.x = 0u; o.y = 0u; }
              *(uint2*)(e.b0 + (row * (unsigned)D + col)) = o;
            }
          }
        }
        __builtin_amdgcn_sched_barrier(0);
      }
    }
  }
}

__device__ __forceinline__ void hyb_prep_phase(const Params& p, float* sm, int bid, int nb) {
  const bf16_t* z = (const bf16_t*)(p.ws + OFF_BIG);
  const float* zg = (const float*)(p.ws + OFF_ZG);
  float* cf = (float*)(p.ws + OFF_CF);
  float* gg = (float*)(p.ws + OFF_GG);
  bf16_t* gp = (bf16_t*)p.out;
  const int tid = otid(); const int lane = tid & 63, wave = tid >> 6;
  for (int item = bid; item < NB * 8; item += nb) {
    const int b = item >> 3, h = item & 7;
    const float bf = p.hyb_fox_bf[h];
    const int p0 = tid * 33;
    float x[33];
    float s = 0.f;
#pragma unroll
    for (int i = 0; i < 33; i++) {
      const int pr = p0 + i;
      float lf = 0.f;
      if (pr >= PADR && pr < LP) lf = logsigf_(zg[((size_t)b * LP + pr) * 16 + h] + bf);
      x[i] = lf; s += lf;
    }
    float inc = s;
#pragma unroll
    for (int o = 1; o < 64; o <<= 1) {
      const float t = __shfl_up(inc, o);
      if (lane >= o) inc += t;
    }
    __syncthreads();
    if (lane == 63) sm[wave] = inc;
    __syncthreads();
    float run = inc - s;
    if (wave > 0) run += sm[0];
    if (wave > 1) run += sm[1];
    if (wave > 2) run += sm[2];
#pragma unroll
    for (int i = 0; i < 33; i++) {
      const int pr = p0 + i;
      run += x[i];
      if (pr < LP) cf[((size_t)b * 8 + h) * LP + pr] = run;
    }
  }
  {
    unsigned* stats = (unsigned*)(p.ws + OFF_STAT);
    for (int it = bid * 4 + wave; it < NB * 8 * 65; it += nb * 4) {
      const int bh = it / 65, seg = it - bh * 65;
      const int b = bh >> 3, h = bh & 7;
      float mq = 0.f, mk = 0.f;
#pragma unroll 4
      for (int g8 = 0; g8 < 16; g8++) {
        const size_t row = (size_t)b * LP + seg * 128 + g8 * 8 + (lane >> 3);
        const uint4 uq = *(const uint4*)(z + row * ZLD + h * 64 + (lane & 7) * 8);
        const uint4 uk = *(const uint4*)(z + row * ZLD + 512 + h * 64 + (lane & 7) * 8);
        const unsigned aq[4] = {uq.x, uq.y, uq.z, uq.w}, ak[4] = {uk.x, uk.y, uk.z, uk.w};
        float sq = 0.f, sk = 0.f;
#pragma unroll
        for (int e = 0; e < 4; e++) {
          const float q0 = bf2f((bf16_t)(aq[e] & 0xffff)), q1 = bf2f((bf16_t)(aq[e] >> 16));
          const float k0 = bf2f((bf16_t)(ak[e] & 0xffff)), k1 = bf2f((bf16_t)(ak[e] >> 16));
          sq += q0 * q0 + q1 * q1; sk += k0 * k0 + k1 * k1;
        }
        mq = fmaxf(mq, dpp_sum8(sq)); mk = fmaxf(mk, dpp_sum8(sk));
      }
#pragma unroll
      for (int o = 32; o > 0; o >>= 1) { mq = fmaxf(mq, __shfl_xor(mq, o)); mk = fmaxf(mk, __shfl_xor(mk, o)); }
      if (lane == 0) { atomicMax(&stats[bh * 2], __float_as_uint(mq)); atomicMax(&stats[bh * 2 + 1], __float_as_uint(mk)); }
    }
  }
  for (int row = bid * 4 + wave; row < R; row += nb * 4) {
    const int pr = row % LP;
    if (pr < PADR) continue;
    float y[12][2];
#pragma unroll
    for (int g = 0; g < 12; g++) {
      const int c = g * 128 + lane * 2;
      float y0 = 0.f, y1 = 0.f;
#pragma unroll
      for (int j = 0; j < 4; j++) {
        const unsigned u = *(const unsigned*)(z + (size_t)(row - 3 + j) * ZLD + 1536 + c);
        const float2 w = *(const float2*)(p.hyb_conv + j * 1536 + c);
        y0 += w.x * bf2f((bf16_t)(u & 0xffff));
        y1 += w.y * bf2f((bf16_t)(u >> 16));
      }
      y[g][0] = siluf_(y0); y[g][1] = siluf_(y1);
    }
#pragma unroll
    for (int g = 0; g < 8; g++) {
      const float n2 = wave_sum_fast(y[g][0] * y[g][0] + y[g][1] * y[g][1]);
      const float sc = rsqrtf(n2 + EPS);
      y[g][0] *= sc; y[g][1] *= sc;
    }
#pragma unroll
    for (int g = 0; g < 12; g++) *(unsigned*)(gp + (size_t)row * 1536 + g * 128 + lane * 2) = pack2(y[g][0], y[g][1]);
    if (lane < 4) {
      const float ga = zg[(size_t)row * 16 + 8 + lane], gb = zg[(size_t)row * 16 + 12 + lane];
      gg[(size_t)row * 8 + lane] = -__expf(p.hyb_a_log[lane]) * softplus_acc(ga + p.hyb_dt_bias[lane]);
      gg[(size_t)row * 8 + 4 + lane] = sigmoidf_(gb);
    }
  }
}

__device__ __forceinline__ void fox_item(const Params& p, int item, float* smf) {
  const int QT = 33;
  const int bh = item / QT, qt = item - bh * QT;
  const int b = bh >> 3, h = bh & 7;
  bf16_t* sm = (bf16_t*)smf;
  float* sC = smf + 8192;
  const bf16_t* z = (const bf16_t*)(p.ws + OFF_BIG);
  const bf16_t* vt = (const bf16_t*)(p.ws + OFF_VT) + (size_t)bh * 64 * LP;
  const float* cf = (const float*)(p.ws + OFF_CF) + (size_t)bh * LP;
  bf16_t* O = (bf16_t*)(p.ws + OFF_O);
  const int tid = otid(), lane = tid & 63, wave = tid >> 6;
  const int fr = lane & 15, g = lane >> 4;
  const int fsw = (fr >> 1) & 7;
  const int q0 = qt * 256, qw0 = q0 + wave * 64;
  const int kdiag = qw0 >> 6;
  const size_t rowb = (size_t)b * LP;
  constexpr float SC2 = 0.18033688011112042f;
  constexpr float LOG2E = 1.4426950408889634f;
  bf16x8 qf[4][2];
#pragma unroll
  for (int qb = 0; qb < 4; qb++) {
    int r = qw0 + qb * 16 + fr; if (r > LP - 1) r = LP - 1;
#pragma unroll
    for (int ks = 0; ks < 2; ks++) qf[qb][ks] = *(const bf16x8*)(z + (rowb + r) * ZLD + h * 64 + ks * 32 + g * 8);
  }
  f32x4 o[4][4];
#pragma unroll
  for (int i = 0; i < 4; i++)
#pragma unroll
    for (int k = 0; k < 4; k++) o[i][k] = (f32x4){0.f, 0.f, 0.f, 0.f};
  float m[4], l[4];
#pragma unroll
  for (int i = 0; i < 4; i++) { m[i] = -1e30f; l[i] = 0.f; }
  int kt_hi = (q0 + 255) >> 6; if (kt_hi > LP / 64 - 1) kt_hi = LP / 64 - 1;
  int kt_lo = 1;
  {
    const unsigned* stats = (const unsigned*)(p.ws + OFF_STAT);
    const float margin = 2.f * 0.125f * sqrtf(__uint_as_float(stats[bh * 2]) * __uint_as_float(stats[bh * 2 + 1]));
    const float cq0 = cf[q0 < PADR ? PADR : q0];
    int found = -1;
#pragma unroll
    for (int base = 0; base < 192; base += 64) {
      const int ktc = base + lane;
      int ke = ktc * 64 + 63; if (ke > LP - 1) ke = LP - 1;
      const bool ok = (ktc >= 1) && (ktc <= kt_hi) && (margin + cq0 - cf[ke] >= -90.f);
      const unsigned long long bal = __ballot(ok);
      if (found < 0 && bal != 0ull) found = base + __ffsll((long long)bal) - 1;
    }
    if (found > 1) kt_lo = found;
  }
  const int lrow = tid >> 3, lchunk = tid & 7;
  const int lsw = ((lchunk ^ ((lrow >> 1) & 7)) << 3);
  uint4 rk0, rk1, rv0, rv1; float rc = 0.f;
#define FOX_LOAD(KT)                                                                         \
  {                                                                                          \
    const bf16_t* kp = z + (rowb + (KT) * 64 + lrow) * ZLD + 512 + h * 64 + lchunk * 8;      \
    rk0 = *(const uint4*)kp; rk1 = *(const uint4*)(kp + (size_t)32 * ZLD);                    \
    const bf16_t* vp = vt + (size_t)lrow * LP + (KT) * 64 + lchunk * 8;                       \
    rv0 = *(const uint4*)vp; rv1 = *(const uint4*)(vp + (size_t)32 * LP);                     \
    if (tid < 64) rc = -cf[(KT) * 64 + tid] * LOG2E;                                          \
  }
#define FOX_STORE(BI)                                                                        \
  {                                                                                          \
    bf16_t* d = sm + (BI) * 8192 + lrow * 64 + lsw;                                          \
    *(uint4*)d = rk0; *(uint4*)(d + 2048) = rk1; *(uint4*)(d + 4096) = rv0; *(uint4*)(d + 4096 + 2048) = rv1; \
    if (tid < 64) sC[(BI) * 64 + tid] = rc;                                                   \
  }
  __syncthreads();
  FOX_LOAD(kt_hi)
  FOX_STORE(0)
  __syncthreads();
  int bi = 0;
  for (int kt = kt_hi; kt >= kt_lo; kt--) {
    if (kt > kt_lo) FOX_LOAD(kt - 1)
    if (kt <= kdiag) {
      const bf16_t* sK = sm + bi * 8192;
      const bf16_t* sV = sK + 4096;
      const float* sCc = sC + bi * 64;
      const bool special = (kt == kdiag) || (kt == 1);
#pragma unroll 1
      for (int ks2 = 0; ks2 < 2; ks2++) {
        f32x4 s[2][4];
#pragma unroll
        for (int kbl = 0; kbl < 2; kbl++)
#pragma unroll
          for (int qb = 0; qb < 4; qb++) s[kbl][qb] = (f32x4){0.f, 0.f, 0.f, 0.f};
#pragma unroll
        for (int kbl = 0; kbl < 2; kbl++) {
#pragma unroll
          for (int ds = 0; ds < 2; ds++) {
            const bf16x8 kf = *(const bf16x8*)(sK + (16 * (2 * ks2 + kbl) + fr) * 64 + (((ds * 4 + g) ^ fsw) << 3));
#pragma unroll
            for (int qb = 0; qb < 4; qb++) s[kbl][qb] = __builtin_amdgcn_mfma_f32_16x16x32_bf16(kf, qf[qb][ds], s[kbl][qb], 0, 0, 0);
          }
        }
        float4 ck[2];
        ck[0] = *(const float4*)(sCc + 16 * (2 * ks2) + 4 * g);
        ck[1] = *(const float4*)(sCc + 16 * (2 * ks2 + 1) + 4 * g);
        float mt[4];
#pragma unroll
        for (int qb = 0; qb < 4; qb++) mt[qb] = -1e30f;
#pragma unroll
        for (int kbl = 0; kbl < 2; kbl++) {
#pragma unroll
          for (int qb = 0; qb < 4; qb++) {
            s[kbl][qb][0] = s[kbl][qb][0] * SC2 + ck[kbl].x;
            s[kbl][qb][1] = s[kbl][qb][1] * SC2 + ck[kbl].y;
            s[kbl][qb][2] = s[kbl][qb][2] * SC2 + ck[kbl].z;
            s[kbl][qb][3] = s[kbl][qb][3] * SC2 + ck[kbl].w;
          }
        }
        if (special) {
#pragma unroll
          for (int kbl = 0; kbl < 2; kbl++)
#pragma unroll
            for (int qb = 0; qb < 4; qb++)
#pragma unroll
              for (int j = 0; j < 4; j++) {
                const int kl = 32 * ks2 + 16 * kbl + 4 * g + j;
                const int ql = 16 * qb + fr;
                bool ok = true;
                if (kt == kdiag) ok = ok && (kl <= ql);
                if (kt == 1) ok = ok && (kl >= 48);
                if (!ok) s[kbl][qb][j] = -1e30f;
              }
        }
#pragma unroll
        for (int kbl = 0; kbl < 2; kbl++)
#pragma unroll
          for (int qb = 0; qb < 4; qb++)
            mt[qb] = fmaxf(mt[qb], fmaxf(fmaxf(s[kbl][qb][0], s[kbl][qb][1]), fmaxf(s[kbl][qb][2], s[kbl][qb][3])));
        bool need = false;
#pragma unroll
        for (int qb = 0; qb < 4; qb++) {
          mt[qb] = fmaxf(mt[qb], __shfl_xor(mt[qb], 16));
          mt[qb] = fmaxf(mt[qb], __shfl_xor(mt[qb], 32));
          need = need || (mt[qb] > m[qb]);
        }
        if (__any(need)) {
#pragma unroll
          for (int qb = 0; qb < 4; qb++) {
            const float mn = fmaxf(m[qb], mt[qb]);
            const float al = __builtin_amdgcn_exp2f(m[qb] - mn);
            m[qb] = mn;
            l[qb] *= al;
#pragma unroll
            for (int db = 0; db < 4; db++) { o[db][qb][0] *= al; o[db][qb][1] *= al; o[db][qb][2] *= al; o[db][qb][3] *= al; }
          }
        }
        bf16x8 pf[4];
#pragma unroll
        for (int qb = 0; qb < 4; qb++) {
          float pv[8];
#pragma unroll
          for (int kbl = 0; kbl < 2; kbl++)
#pragma unroll
            for (int j = 0; j < 4; j++) {
              const float e = __builtin_amdgcn_exp2f(s[kbl][qb][j] - m[qb]);
              pv[kbl * 4 + j] = e;
              l[qb] += e;
            }
          union { bf16x8 v; unsigned u[4]; } cv;
          cv.u[0] = pack2(pv[0], pv[1]); cv.u[1] = pack2(pv[2], pv[3]); cv.u[2] = pack2(pv[4], pv[5]); cv.u[3] = pack2(pv[6], pv[7]);
          pf[qb] = cv.v;
        }
#pragma unroll
        for (int db = 0; db < 4; db++) {
          const int c0 = 4 * ks2 + (g >> 1);
          const bf16_t* vr = sV + (16 * db + fr) * 64 + (g & 1) * 4;
          union { bf16x8 v; uint2 u[2]; } vf;
          vf.u[0] = *(const uint2*)(vr + ((c0 ^ fsw) << 3));
          vf.u[1] = *(const uint2*)(vr + (((c0 + 2) ^ fsw) << 3));
#pragma unroll
          for (int qb = 0; qb < 4; qb++) o[db][qb] = __builtin_amdgcn_mfma_f32_16x16x32_bf16(vf.v, pf[qb], o[db][qb], 0, 0, 0);
        }
      }
    }
    if (kt > kt_lo) FOX_STORE(bi ^ 1)
    __syncthreads();
    bi ^= 1;
  }
#undef FOX_LOAD
#undef FOX_STORE
#pragma unroll
  for (int qb = 0; qb < 4; qb++) {
    float lt = l[qb];
    lt += __shfl_xor(lt, 16);
    lt += __shfl_xor(lt, 32);
    const int r = qw0 + qb * 16 + fr;
    if (r >= PADR && r < LP) {
      const float inv = 1.f / lt;
      bf16_t* op = O + (rowb + r) * D + h * 64 + 4 * g;
#pragma unroll
      for (int db = 0; db < 4; db++) {
        uint2 u;
        u.x = pack2(o[db][qb][0] * inv, o[db][qb][1] * inv);
        u.y = pack2(o[db][qb][2] * inv, o[db][qb][3] * inv);
        *(uint2*)(op + 16 * db) = u;
      }
    }
  }
}


__device__ __forceinline__ void gdn_item(const Params& p, int item, float* sm) {
  const int b = item >> 5, h = (item >> 3) & 3, c0 = (item & 7) * 16;
  const bf16_t* gp = (const bf16_t*)p.out;
  const float* gg = (const float*)(p.ws + OFF_GG);
  bf16_t* O = (bf16_t*)(p.ws + OFF_O);
  constexpr int TC = 16;
  constexpr int BUF = 2 * TC * 128 + TC * 16 + 2 * TC + TC * 16 + TC;
  const int tid = otid(), lane = tid & 63, wave = tid >> 6;
  const int sub = lane & 15, cw = wave * 4 + (lane >> 4);
  const int ltt = tid >> 4, lseg = tid & 15;
  float S[8];
#pragma unroll
  for (int i = 0; i < 8; i++) S[i] = 0.f;
  const size_t rowb = (size_t)b * LP;
  uint4 pq, pk; bf16_t pv; float pg = 0.f, pb = 0.f;
#define GDN_LOAD(T0)                                                                 \
  {                                                                                  \
    const size_t row = rowb + (T0) + ltt;                                            \
    pq = *(const uint4*)(gp + row * 1536 + h * 128 + lseg * 8);                      \
    pk = *(const uint4*)(gp + row * 1536 + 512 + h * 128 + lseg * 8);                \
    pv = gp[row * 1536 + 1024 + h * 128 + c0 + lseg];                                \
    if (tid < TC) { pg = gg[(rowb + (T0) + tid) * 8 + h]; pb = gg[(rowb + (T0) + tid) * 8 + 4 + h]; } \
  }
#define GDN_STORE(BI)                                                                \
  {                                                                                  \
    float* bq = sm + (BI) * BUF + ltt * 128 + lseg * 8;                              \
    float* bk = bq + TC * 128;                                                       \
    *(float4*)(bq) = make_float4(bf2f((bf16_t)(pq.x & 0xffff)), bf2f((bf16_t)(pq.x >> 16)), bf2f((bf16_t)(pq.y & 0xffff)), bf2f((bf16_t)(pq.y >> 16))); \
    *(float4*)(bq + 4) = make_float4(bf2f((bf16_t)(pq.z & 0xffff)), bf2f((bf16_t)(pq.z >> 16)), bf2f((bf16_t)(pq.w & 0xffff)), bf2f((bf16_t)(pq.w >> 16))); \
    *(float4*)(bk) = make_float4(bf2f((bf16_t)(pk.x & 0xffff)), bf2f((bf16_t)(pk.x >> 16)), bf2f((bf16_t)(pk.y & 0xffff)), bf2f((bf16_t)(pk.y >> 16))); \
    *(float4*)(bk + 4) = make_float4(bf2f((bf16_t)(pk.z & 0xffff)), bf2f((bf16_t)(pk.z >> 16)), bf2f((bf16_t)(pk.w & 0xffff)), bf2f((bf16_t)(pk.w >> 16))); \
    sm[(BI) * BUF + 2 * TC * 128 + ltt * 16 + lseg] = bf2f(pv);                       \
    {                                                                                \
      const float4 qa_ = *(const float4*)(bq), qb_ = *(const float4*)(bq + 4);       \
      const float4 ka_ = *(const float4*)(bk), kb_ = *(const float4*)(bk + 4);       \
      const float part_ = (qa_.x * ka_.x + qa_.y * ka_.y + qa_.z * ka_.z + qa_.w * ka_.w) + \
                          (qb_.x * kb_.x + qb_.y * kb_.y + qb_.z * kb_.z + qb_.w * kb_.w);  \
      const float tot_ = dpp_sum16(part_);                                           \
      if (lseg == 0) sm[(BI) * BUF + 2 * TC * 128 + TC * 16 + 2 * TC + TC * 16 + ltt] = tot_; \
    }                                                                                \
    if (tid < TC) { sm[(BI) * BUF + 2 * TC * 128 + TC * 16 + tid] = __expf(pg); sm[(BI) * BUF + 2 * TC * 128 + TC * 16 + TC + tid] = pb; } \
  }
  __syncthreads();
  GDN_LOAD(PADR)
  GDN_STORE(0)
  __syncthreads();
  constexpr int NCH = (LP - PADR) / TC;
  for (int ch = 0; ch < NCH; ch++) {
    const int bi = ch & 1;
    const int t0 = PADR + ch * TC;
    if (ch + 1 < NCH) GDN_LOAD(t0 + TC)
    {
      const float* bq = sm + bi * BUF;
      const float* bk = bq + TC * 128;
      const float* bv = bq + 2 * TC * 128;
      const float* bg = bv + TC * 16;
      float* bo = sm + bi * BUF + 2 * TC * 128 + TC * 16 + 2 * TC;
      float oreg[TC];
#pragma unroll
      for (int t = 0; t < TC; t++) {
        const float4 k0 = *(const float4*)(bk + t * 128 + sub * 8);
        const float4 k1 = *(const float4*)(bk + t * 128 + sub * 8 + 4);
        const float4 q0 = *(const float4*)(bq + t * 128 + sub * 8);
        const float4 q1 = *(const float4*)(bq + t * 128 + sub * 8 + 4);
        const float v = bv[t * 16 + cw];
        const float g = bg[t], be = bg[TC + t];
        const float qk = bo[TC * 16 + t];
        float pa = k0.x * S[0] + k0.y * S[1];
        float pb2 = k0.z * S[2] + k0.w * S[3];
        float qa = q0.x * S[0] + q0.y * S[1];
        float qb2 = q0.z * S[2] + q0.w * S[3];
        pa += k1.x * S[4] + k1.y * S[5];
        pb2 += k1.z * S[6] + k1.w * S[7];
        qa += q1.x * S[4] + q1.y * S[5];
        qb2 += q1.z * S[6] + q1.w * S[7];
        const float ks = dpp_sum16(pa + pb2);
        const float qs = dpp_sum16(qa + qb2);
        const float coef = be * (v - g * ks);
        const float oo = g * qs + coef * qk;
        S[0] = g * S[0] + coef * k0.x; S[1] = g * S[1] + coef * k0.y; S[2] = g * S[2] + coef * k0.z; S[3] = g * S[3] + coef * k0.w;
        S[4] = g * S[4] + coef * k1.x; S[5] = g * S[5] + coef * k1.y; S[6] = g * S[6] + coef * k1.z; S[7] = g * S[7] + coef * k1.w;
        oreg[t] = oo * 0.08838834764831845f;
      }
      if (sub == 0) {
#pragma unroll
        for (int t = 0; t < TC; t++) bo[t * 16 + cw] = oreg[t];
      }
    }
    if (ch + 1 < NCH) GDN_STORE(bi ^ 1)
    __syncthreads();
    {
      const float ov = sm[bi * BUF + 2 * TC * 128 + TC * 16 + 2 * TC + ltt * 16 + lseg];
      O[(rowb + t0 + ltt) * D + 512 + h * 128 + c0 + lseg] = f2bf(ov);
    }
  }
#undef GDN_LOAD
#undef GDN_STORE
  __syncthreads();
}

__device__ __forceinline__ void gdn_norm_phase(const Params& p, int bid, int nb) {
  const bf16_t* z = (const bf16_t*)(p.ws + OFF_BIG);
  bf16_t* O = (bf16_t*)(p.ws + OFF_O);
  const int tid_ = otid(); const int lane = tid_ & 63, wave = tid_ >> 6;
  const float g0 = p.hyb_o_gain[lane * 2], g1 = p.hyb_o_gain[lane * 2 + 1];
  for (int row = bid * 4 + wave; row < R; row += nb * 4) {
    if ((row % LP) < PADR) continue;
    unsigned u[4], gz[4];
#pragma unroll
    for (int h = 0; h < 4; h++) {
      u[h] = *(const unsigned*)(O + (size_t)row * D + 512 + h * 128 + lane * 2);
      gz[h] = *(const unsigned*)(z + (size_t)row * ZLD + 3072 + h * 128 + lane * 2);
    }
#pragma unroll
    for (int h = 0; h < 4; h++) {
      const float o0 = bf2f((bf16_t)(u[h] & 0xffff)), o1 = bf2f((bf16_t)(u[h] >> 16));
      const float ss = wave_sum_fast(o0 * o0 + o1 * o1);
      const float sc = rsqrtf(ss * (1.f / 128.f) + EPS);
      const float z0 = bf2f((bf16_t)(gz[h] & 0xffff)), z1 = bf2f((bf16_t)(gz[h] >> 16));
      *(unsigned*)(O + (size_t)row * D + 512 + h * 128 + lane * 2) = pack2(o0 * sc * g0 * siluf_(z0), o1 * sc * g1 * siluf_(z1));
    }
  }
}

__device__ __forceinline__ void mixer0_phase(const Params& p, float* sm, int bid, int nb) {
  const int nfox = NB * 8 * 33;
  if (nb > 128) {
    if (bid < 128) {
      gdn_item(p, bid, sm);
    } else {
      for (int f = bid - 128; f < nfox; f += nb - 128) {
        const int qt = 32 - f / 32, bh = f % 32;
        fox_item(p, bh * 33 + qt, sm);
      }
    }
  } else {
    for (int it = bid; it < 128 + nfox; it += nb) {
      if (it < 128) gdn_item(p, it, sm);
      else { const int f = it - 128; const int qt = 32 - f / 32, bh = f % 32; fox_item(p, bh * 33 + qt, sm); }
    }
  }
}

__device__ __forceinline__ bf16_t* yraw_ptr(const Params& p, int b) {
  return (b < 2) ? ((bf16_t*)(p.ws + WS_END) + (size_t)b * LP * D) : ((bf16_t*)((char*)p.out + SZ_O) + (size_t)(b - 2) * LP * D);
}

__device__ __forceinline__ void rwkv_item(const Params& p, int item, float* sm) {
  const int bh = item >> 2, rg = item & 3;
  const int b = bh >> 4, h = bh & 15;
  const bf16_t* rkv = (const bf16_t*)(p.ws + OFF_RKV);
  const bf16_t* aa = (const bf16_t*)p.out;
  const bf16_t* wexp = (const bf16_t*)(p.ws + OFF_O);
  float* SB = (float*)(p.ws + OFF_ZG);
  float* MU = (float*)(p.ws + OFF_MU);
  bf16_t* yr = yraw_ptr(p, b);
  constexpr int TC = 16;
  constexpr int BUF = 5 * TC * 64 + TC * 16 + TC + TC * 16;
  const int tid = otid(), lane = tid & 63, wave = tid >> 6;
  const int sub = lane & 15, rowl = wave * 4 + (lane >> 4);
  const int ltt = tid >> 4, lrr = tid & 15;
  const int ch = h * 64 + lane;
  const float kkw = p.k_k[ch], kaw = p.k_a[ch], rkw = p.r_k[ch];
  const size_t rowb = (size_t)b * LP;
  float S0 = 0.f, S1 = 0.f, S2 = 0.f, S3 = 0.f;
  bf16_t pr0, pr1, pr2, pr3, pk0, pk1, pk2, pk3, pa0, pa1, pa2, pa3, pw0, pw1, pw2, pw3, pv;
#define RW_LOAD1(I, PR, PK, PA, PW)                                        \
  {                                                                        \
    const size_t row = rowb + T0_ + 4 * wave + (I);                        \
    PR = rkv[row * RKLD + ch]; PK = rkv[row * RKLD + 1024 + ch];           \
    PA = aa[row * D + ch]; PW = wexp[row * D + ch];                        \
  }
#define RW_LOAD(T0)                                                        \
  {                                                                        \
    const int T0_ = (T0);                                                  \
    RW_LOAD1(0, pr0, pk0, pa0, pw0) RW_LOAD1(1, pr1, pk1, pa1, pw1)        \
    RW_LOAD1(2, pr2, pk2, pa2, pw2) RW_LOAD1(3, pr3, pk3, pa3, pw3)        \
    pv = rkv[(rowb + T0_ + ltt) * RKLD + 2048 + h * 64 + rg * 16 + lrr];   \
  }
#define RW_PREP1(I, PR, PK, PA, PW)                                        \
  {                                                                        \
    const int t = 4 * wave + (I);                                          \
    const float r = bf2f(PR), kr = bf2f(PK), a = bf2f(PA), we = bf2f(PW);  \
    const float kkv = kr * kkw;                                            \
    const float n2 = wave_sum_fast(kkv * kkv);                             \
    const float kk = kkv * rsqrtf(n2 + EPS);                               \
    const float kp = kr * (1.f + (a - 1.f) * kaw);                         \
    const float sb = wave_sum_fast(r * kp * rkw);                          \
    bb_[0 * TC * 64 + t * 64 + lane] = __expf(-we);                        \
    bb_[1 * TC * 64 + t * 64 + lane] = kp;                                 \
    bb_[2 * TC * 64 + t * 64 + lane] = -kk;                                \
    bb_[3 * TC * 64 + t * 64 + lane] = kk * a;                             \
    bb_[4 * TC * 64 + t * 64 + lane] = r;                                  \
    if (lane == 0 && rg == 0) SB[(rowb + TS_ + t) * 16 + h] = sb;          \
  }
#define RW_STORE(BI, TS)                                                   \
  {                                                                        \
    const int TS_ = (TS);                                                  \
    float* bb_ = sm + (BI) * BUF;                                          \
    RW_PREP1(0, pr0, pk0, pa0, pw0) RW_PREP1(1, pr1, pk1, pa1, pw1)        \
    RW_PREP1(2, pr2, pk2, pa2, pw2) RW_PREP1(3, pr3, pk3, pa3, pw3)        \
    bb_[5 * TC * 64 + ltt * 16 + lrr] = bf2f(pv);                          \
  }
  __syncthreads();
  RW_LOAD(PADR)
  RW_STORE(0, PADR)
  __syncthreads();
  constexpr int NCH = (LP - PADR) / TC;
  for (int c = 0; c < NCH; c++) {
    const int bi = c & 1;
    const int t0 = PADR + c * TC;
    if (c + 1 < NCH) RW_LOAD(t0 + TC)
    {
      const float* bw = sm + bi * BUF;
      const float* bv = bw + 5 * TC * 64;
      float* by = sm + bi * BUF + 5 * TC * 64 + TC * 16 + TC;
      float yreg[TC];
#pragma unroll
      for (int t = 0; t < TC; t++) {
        const float4 w4 = *(const float4*)(bw + 0 * TC * 64 + t * 64 + sub * 4);
        const float4 k4 = *(const float4*)(bw + 1 * TC * 64 + t * 64 + sub * 4);
        const float4 a4 = *(const float4*)(bw + 2 * TC * 64 + t * 64 + sub * 4);
        const float4 b4 = *(const float4*)(bw + 3 * TC * 64 + t * 64 + sub * 4);
        const float4 r4 = *(const float4*)(bw + 4 * TC * 64 + t * 64 + sub * 4);
        const float v = bv[t * 16 + rowl];
        const float sa = dpp_sum16((S0 * a4.x + S1 * a4.y) + (S2 * a4.z + S3 * a4.w));
        S0 = S0 * w4.x + (sa * b4.x + v * k4.x);
        S1 = S1 * w4.y + (sa * b4.y + v * k4.y);
        S2 = S2 * w4.z + (sa * b4.z + v * k4.z);
        S3 = S3 * w4.w + (sa * b4.w + v * k4.w);
        const float y = dpp_sum16((S0 * r4.x + S1 * r4.y) + (S2 * r4.z + S3 * r4.w));
        yreg[t] = y;
      }
      if (sub == 0) {
#pragma unroll
        for (int t = 0; t < TC; t++) by[t * 16 + rowl] = yreg[t];
      }
    }
    if (c + 1 < NCH) RW_STORE(bi ^ 1, t0 + TC)
    __syncthreads();
    {
      const float* bb = sm + bi * BUF;
      const float yv = bb[5 * TC * 64 + TC * 16 + TC + ltt * 16 + lrr];
      const float mu = dpp_sum16(yv) * (1.f / 16.f);
      yr[(size_t)(t0 + ltt) * D + h * 64 + rg * 16 + lrr] = f2bf(yv - mu);
      if (lrr == 0) MU[(rowb + t0 + ltt) * 64 + h * 4 + rg] = mu;
    }
  }
#undef RW_LOAD1
#undef RW_LOAD
#undef RW_PREP1
#undef RW_STORE
  __syncthreads();
}

__device__ __forceinline__ void rwkv_phase(const Params& p, float* sm, int bid, int nb) {
  for (int item = bid; item < 256; item += nb) rwkv_item(p, item, sm);
}

__device__ __forceinline__ void rwkv_gn_phase(const Params& p, int bid, int nb) {
  bf16_t* rkv = (bf16_t*)(p.ws + OFF_RKV);
  const float* SB = (const float*)(p.ws + OFF_ZG);
  const float* MU = (const float*)(p.ws + OFF_MU);
  const int tid_ = otid(); const int lane = tid_ & 63, wave = tid_ >> 6;
  for (int it = bid * 4 + wave; it < R * 16; it += nb * 4) {
    const int row = it >> 4, h = it & 15;
    const int b = row / LP, pr = row - b * LP;
    if (pr < PADR) continue;
    const int ch = h * 64 + lane;
    const float y = bf2f(yraw_ptr(p, b)[(size_t)pr * D + ch]) + MU[(size_t)row * 64 + h * 4 + (lane >> 4)];
    const float v = bf2f(rkv[(size_t)row * RKLD + 2048 + ch]);
    const float sb = SB[(size_t)row * 16 + h];
    const float mean = wave_sum(y) * (1.f / 64.f);
    const float dv = y - mean;
    const float var = wave_sum(dv * dv) * (1.f / 64.f);
    rkv[(size_t)row * RKLD + 2048 + ch] = f2bf(dv * rsqrtf(var + 64e-5f) * p.ln_w[ch] + p.ln_b[ch] + sb * v);
  }
}


#define XB_TMO      128
#define XB_XCNT(j)  (256  + 64 * (j))
#define XB_XSUB(j)  (1280 + 64 * (j))
#define XB_XGEN(j)  (2304 + 64 * (j))
#define XB_TOP      3328
#define XB_TOPGEN   3392
#define XCD_BAR_WORDS 3456
#define XB_SPIN_CAP (1u << 18)
__device__ __forceinline__ unsigned xb_ld(unsigned* p) { return __hip_atomic_load(p, __ATOMIC_RELAXED, __HIP_MEMORY_SCOPE_AGENT); }
__device__ __forceinline__ unsigned xb_add(unsigned* p, unsigned v) { return __hip_atomic_fetch_add(p, v, __ATOMIC_RELAXED, __HIP_MEMORY_SCOPE_AGENT); }
__device__ __forceinline__ unsigned xb_xcc_id() { return (unsigned)__builtin_amdgcn_s_getreg((3 << 11) | 20) & 0xFu; }
#define XB_SPIN(cond, bar) do { unsigned _sp = 0; while (cond) { __builtin_amdgcn_s_sleep(1); \
    if ((++_sp & 255u) == 0u) { if (xb_ld(&(bar)[XB_TMO])) break; if (_sp > XB_SPIN_CAP) { atomicAdd(&(bar)[XB_TMO], 1u); break; } } } } while (0)

__device__ __forceinline__ void xcd_barrier_complete(unsigned* bar, unsigned x, unsigned& nloc, unsigned& nx) {
  const unsigned G = gridDim.x;
  unsigned sum, cnt, mine, sp = 0u;
  for (;;) {
    sum = 0u; cnt = 0u; mine = 0u;
#pragma unroll
    for (unsigned j = 0; j < 16; ++j) { const unsigned c = xb_ld(&bar[XB_XCNT(j)]); sum += c; cnt += (c > 0u) ? 1u : 0u; mine = (j == x) ? c : mine; }
    if (sum == G) break;
    __builtin_amdgcn_s_sleep(1);
    if ((++sp & 255u) == 0u) { if (xb_ld(&bar[XB_TMO])) break; if (sp > XB_SPIN_CAP) { atomicAdd(&bar[XB_TMO], 1u); break; } }
  }
  nloc = mine > 0u ? mine : 1u; nx = cnt > 0u ? cnt : 1u;
}

__device__ __forceinline__ void xcd_barrier(unsigned* bar, unsigned x, unsigned& nloc, unsigned& nx) {
  asm volatile("s_waitcnt vmcnt(0)" ::: "memory");
  __syncthreads();
  if (threadIdx.x == 0) {
    __builtin_amdgcn_s_waitcnt(0);
    if (nloc == 0u) xcd_barrier_complete(bar, x, nloc, nx);
    const unsigned old = xb_add(&bar[XB_XSUB(x)], 1u);
    const unsigned gen = old / nloc;
    if (old + 1u == (gen + 1u) * nloc) {
      __builtin_amdgcn_fence(__ATOMIC_RELEASE, "agent");
      asm volatile("s_waitcnt vmcnt(0)" ::: "memory");
      const unsigned og = xb_add(&bar[XB_TOP], 1u);
      const unsigned tg = og / nx;
      if (og + 1u == (tg + 1u) * nx) xb_add(&bar[XB_TOPGEN], 1u);
      else XB_SPIN(xb_ld(&bar[XB_TOPGEN]) == tg, bar);
      __builtin_amdgcn_fence(__ATOMIC_ACQUIRE, "agent");
      xb_add(&bar[XB_XGEN(x)], 1u);
      asm volatile("s_waitcnt vmcnt(0)" ::: "memory");
    } else {
      XB_SPIN(xb_ld(&bar[XB_XGEN(x)]) == gen, bar);
      __builtin_amdgcn_fence(__ATOMIC_ACQUIRE, "agent");
      asm volatile("s_waitcnt vmcnt(0)" ::: "memory");
    }
  }
  __syncthreads();
}

constexpr int NPHASE = 25;
constexpr int LDS_BYTES = 65536;

__device__ __forceinline__ void run_phase(const Params& p, int ph, char* smraw, int bid, int nb) {
  bf16_t* smb = (bf16_t*)smraw;
  float* smf = (float*)smraw;
  bf16_t* wb = (bf16_t*)(p.ws + OFF_WB);
  bf16_t* wm = (bf16_t*)((char*)p.out + OUT_W1M) - W1_G1;
  float* H = (float*)(p.ws + OFF_H);
  bf16_t* hn = (bf16_t*)p.out + D;
  bf16_t* big = (bf16_t*)(p.ws + OFF_BIG);
  bf16_t* obuf = (bf16_t*)(p.ws + OFF_O);
  bf16_t* mid = (bf16_t*)(p.ws + OFF_MID);
  Epi e; e.f0 = nullptr; e.b0 = nullptr; e.b1 = nullptr; e.v0 = nullptr; e.c0 = nullptr; e.alpha = 0.f;
  e.y01 = nullptr; e.y23 = nullptr; e.mu = nullptr; e.sbp = nullptr; e.lnw = nullptr; e.lnb = nullptr;
  int kind = 7;
  const bf16_t* A = nullptr; int lda = 0; const bf16_t* W = nullptr; int K = 0; int ntn = 0;
  const float* gain = nullptr; int layer = 0;
  switch (ph) {
    case 0: kind = 0; layer = 0; gain = p.ffn_norm + 0 * D; break;
    case 1: kind = 1; W = wb + W0_FIN_A; break;
    case 2: kind = 2; A = big; lda = DFF; W = wb + W0_FOUT_A; K = DFF; e.alpha = 0.5f; break;
    case 3: kind = 3; gain = p.mix_norm + 0 * D; break;
    case 4: kind = 4; break;
    case 5: kind = 5; break;
    case 6: kind = 6; break;
    case 7: kind = 13; break;
    case 8: kind = 2; A = obuf; lda = D; W = wb + W0_HOUT; K = 1024; e.alpha = 1.f; break;
    case 9: kind = 3; gain = p.ffn_norm + 1 * D; break;
    case 10: kind = 1; W = wb + W0_FIN_B; break;
    case 11: kind = 2; A = big; lda = DFF; W = wb + W0_FOUT_B; K = DFF; e.alpha = 0.5f; break;
    case 12: kind = 0; layer = 1; gain = p.ffn_norm + 2 * D; break;
    case 13: kind = 1; W = wb + W1_FIN_A; break;
    case 14: kind = 2; A = big; lda = DFF; W = wb + W1_FOUT_A; K = DFF; e.alpha = 0.5f; break;
    case 15: kind = 3; gain = p.mix_norm + 1 * D; break;
    case 16: kind = 8; break;
    case 17: kind = 9; break;
    case 18: kind = 10; break;
    case 19: kind = 11; break;
    case 20: kind = 2; A = obuf; lda = D; W = wm + W1_WO; K = 1024; e.alpha = 1.f; break;
    case 21: kind = 3; gain = p.ffn_norm + 3 * D; break;
    case 22: kind = 1; W = wb + W1_FIN_B; break;
    case 23: kind = 2; A = big; lda = DFF; W = wb + W1_FOUT_B; K = DFF; e.alpha = 0.5f; break;
    case 24: kind = 12; break;
    default: break;
  }
  bool prep_after = false;
  if (kind == 6) {
    const int rk = ((const int*)(p.ws + OFF_RANK))[bid];
    const int np = (int)*(const unsigned*)(p.ws + OFF_NPRIM);
    if (rk < 0) {
      const int idle_rank = ((const int*)(p.ws + OFF_RANK))[512 + bid];
      prep_weights(p, 1, 1 | 4, smf, idle_rank, nb - np);
      return;
    }
    prep_after = (np >= nb);
    bid = rk; nb = np;
  }
  switch (kind) {
    case 0:
      if (layer == 0) prep_weights(p, 0, 7, smf, bid, nb);
      if (layer == 0) norm_phase<1>(p, gain, hn, bid, nb); else norm_phase<0>(p, gain, hn, bid, nb);
      break;
    case 1: e.b0 = big;
      if (nb == 512) {
        gemm_phase<EPI_SWIGLU, false, 256>(hn, D, W, 1024, 44, e, smb, bid, nb, 0, 5632);
        gemm_phase<EPI_SWIGLU, false>(hn, D, W, 1024, 44, e, smb, bid, nb, 11264, 11440);
      } else gemm_phase<EPI_SWIGLU, false, 256>(hn, D, W, 1024, 44, e, smb, bid, nb);
      break;
    case 2: e.f0 = H;
      if (nb == 512) {
        gemm_phase<EPI_RESID, false, 256>(A, lda, W, K, 8, e, smb, bid, nb, 0, 1024);
        gemm_phase<EPI_RESID, false>(A, lda, W, K, 8, e, smb, bid, nb, 2048, 2080);
      } else gemm_phase<EPI_RESID, false>(A, lda, W, K, 8, e, smb, bid, nb);
      break;
    case 3: norm_phase<0>(p, gain, hn, bid, nb); break;
    case 4: e.b0 = big; e.f0 = (float*)(p.ws + OFF_ZG); e.b1 = (bf16_t*)(p.ws + OFF_VT);
      gemm_phase<EPI_HYB, false, 256>(hn, D, wb + W0_HIN, 1024, HYB_NP / 128, e, smb, bid, nb); break;
    case 5: hyb_prep_phase(p, smf, bid, nb); break;
#ifndef SKIP_MIX
    case 6: mixer0_phase(p, smf, bid, nb); if (prep_after) { __syncthreads(); prep_weights(p, 1, 1 | 4, smf, bid, nb); } break;
#endif
    case 8: e.b0 = (bf16_t*)(p.ws + OFF_RKV); e.b1 = mid;
      gemm_phase<EPI_RK1, true, 256>(hn, D, wm + W1_G1, 2048, RK_NP / 128, e, smb, bid, nb); break;
    case 9:
      e.b0 = obuf; e.v0 = p.w0;
      gemm_phase<EPI_LW, false>(mid, MIDLD, wm + W1_W2, 64, 8, e, smb, bid, nb);
      e.b0 = (bf16_t*)p.out; e.v0 = p.a0;
      gemm_phase<EPI_LA, false>(mid + 64, MIDLD, wm + W1_A2, 64, 8, e, smb, bid, nb);
      break;
#ifndef SKIP_RWKV
    case 10:
      if (nb == 512 && bid >= 256) prep_weights(p, 1, 2, smf, bid - 256, 256);
      else { if (nb != 512) prep_weights(p, 1, 2, smf, bid, nb); rwkv_phase(p, smf, bid, nb); }
      break;
#endif
    case 11: e.b0 = obuf; e.c0 = (const bf16_t*)(p.ws + OFF_RKV);
      e.y01 = (const bf16_t*)(p.ws + WS_END); e.y23 = (const bf16_t*)((const char*)p.out + SZ_O); e.mu = (const float*)(p.ws + OFF_MU);
      e.sbp = (const float*)(p.ws + OFF_ZG); e.lnw = p.ln_w; e.lnb = p.ln_b;
      gemm_phase<EPI_LG, false>(mid + 128, MIDLD, wm + W1_G2, 192, 8, e, smb, bid, nb); break;
    case 12: final_phase(p, bid, nb); break;
    case 13: gdn_norm_phase(p, bid, nb); break;
    case 14: rwkv_gn_phase(p, bid, nb); break;
    default: break;
  }
}

#if MEGA
__global__ void __launch_bounds__(256, 2) mega_kernel(Params p) {
  __shared__ __attribute__((aligned(16))) char smraw[LDS_BYTES];
  cg::grid_group grid = cg::this_grid();
  unsigned* bar = (unsigned*)(p.ws + OFF_BAR);
  const unsigned xcc = xb_xcc_id();
  unsigned nloc = 0u, nx = 0u;
  if (threadIdx.x == 0) {
    (void)xb_add(&bar[XB_XCNT(xcc)], 1u);
    const unsigned hwid = (unsigned)__builtin_amdgcn_s_getreg((7 << 11) | (8 << 6) | 4);
    const unsigned key = (xcc << 8) | (hwid & 0xFFu);
    unsigned* cucnt = (unsigned*)(p.ws + OFF_CUCNT);
    int rk = -1;
    if (xb_add(&cucnt[key], 1u) == 0u) rk = (int)xb_add((unsigned*)(p.ws + OFF_NPRIM), 1u);
    ((int*)(p.ws + OFF_RANK))[blockIdx.x] = rk;
    ((int*)(p.ws + OFF_RANK))[512 + blockIdx.x] = (rk < 0) ? (int)xb_add((unsigned*)(p.ws + OFF_NPRIM) + 16, 1u) : -1;
  }
  for (int ph = 0; ph < NPHASE; ph++) {
    run_phase(p, ph, smraw, blockIdx.x, gridDim.x);
    if (ph + 1 < NPHASE) {
      if (ph == 0) grid.sync();
      else xcd_barrier(bar, xcc, nloc, nx);
    }
  }
}
#else
template <int PH>
__global__ void __launch_bounds__(256) phase_kernel(Params p) {
  __shared__ __attribute__((aligned(16))) char smraw[LDS_BYTES];
  run_phase(p, PH, smraw, blockIdx.x, gridDim.x);
}
template <int PH>
static void launch_all(const Params& p, hipStream_t stream) {
  if constexpr (PH < NPHASE) {
    if (PH != 7) phase_kernel<PH><<<512, 256, 0, stream>>>(p);
    launch_all<PH + 1>(p, stream);
  }
}
#endif

extern "C" void kernel_launch(void* const* d_in, const int* in_sizes, int n_in, void* d_out, int out_size, void* d_ws,
                              size_t ws_size, hipStream_t stream) {
  Params p{};
  const float** pp = (const float**)&p;
  for (int i = 0; i < 32; i++) pp[i] = (const float*)d_in[i];
  p.out = (float*)d_out;
  p.ws = (char*)d_ws;
#if MEGA
  static int grid_blocks = 0;
  if (!grid_blocks) {
    int dev = 0, cus = 0, per_cu = 0;
    hipGetDevice(&dev);
    hipDeviceGetAttribute(&cus, hipDeviceAttributeMultiprocessorCount, dev);
    hipOccupancyMaxActiveBlocksPerMultiprocessor(&per_cu, mega_kernel, 256, 0);
    if (per_cu > 2) per_cu = 2;
    if (per_cu < 1) per_cu = 1;
    grid_blocks = cus * per_cu;
  }
  hipMemsetAsync((char*)d_ws + OFF_BAR, 0, SZ_SYNC, stream);
  void* args[] = {&p};
  hipError_t err = hipLaunchCooperativeKernel((void*)mega_kernel, dim3(grid_blocks), dim3(256), args, 0, stream);
  if (err != hipSuccess) fprintf(stderr, "cooperative launch failed: %s (grid %d)\n", hipGetErrorString(err), grid_blocks);
#else
  launch_all<0>(p, stream);
#endif
}
```

```cpp
#include <hip/hip_runtime.h>
#include <hip/hip_cooperative_groups.h>
#include <stdint.h>
#include <stdio.h>
namespace cg = cooperative_groups;

#ifndef MEGA
#define MEGA 1
#endif

typedef unsigned short bf16_t;
using bf16x8 = __attribute__((ext_vector_type(8))) short;
using f32x4 = __attribute__((ext_vector_type(4))) float;

constexpr int NB = 4;
constexpr int SEQ = 8192;
constexpr int NMETA = 16;
constexpr int PADR = 112;
constexpr int LP = 8320;
constexpr int R = NB * LP;
constexpr int D = 1024;
constexpr int DFF = 2816;
constexpr int MT = R / 128;
constexpr float EPS = 1e-6f;

constexpr int ZLD = 3584;
constexpr int HYB_NP = 3712;
constexpr int RK_NP = 3456;
constexpr int RKLD = 3072;
constexpr int MIDLD = 320;

constexpr size_t OFF_H = 0;
constexpr size_t SZ_H = (size_t)R * D * 4;
constexpr size_t OFF_WB = OFF_H + SZ_H;
constexpr size_t SZ_WB = (size_t)52 << 20;
constexpr size_t OFF_BIG = OFF_WB + SZ_WB;
constexpr size_t SZ_BIG = (size_t)R * ZLD * 2;
constexpr size_t OFF_ZG = OFF_BIG + SZ_BIG;
constexpr size_t SZ_ZG = (size_t)R * 16 * 4;
constexpr size_t OFF_CF = OFF_ZG + SZ_ZG;
constexpr size_t SZ_CF = (size_t)NB * 8 * LP * 4;
constexpr size_t OFF_GG = OFF_CF + SZ_CF;
constexpr size_t SZ_GG = (size_t)R * 8 * 4;
constexpr size_t OFF_O = OFF_GG + SZ_GG;
constexpr size_t SZ_O = (size_t)R * D * 2;
constexpr size_t WS_END = OFF_O + SZ_O;
constexpr size_t OFF_VT = WS_END;
constexpr size_t SZ_VT = (size_t)NB * 8 * 64 * LP * 2;
constexpr size_t OFF_BAR = OFF_VT + SZ_VT;
constexpr size_t OFF_STAT = OFF_BAR + 16384;
constexpr size_t OFF_CUCNT = OFF_STAT + 256;
constexpr size_t OFF_NPRIM = OFF_CUCNT + 16384;
constexpr size_t OFF_RANK = OFF_NPRIM + 256;
constexpr size_t SZ_SYNC = 16384 + 256 + 16384 + 256 + 4096;
static_assert(OFF_BAR + SZ_SYNC <= ((size_t)512 << 20), "ws overflow");
constexpr size_t OFF_RKV = OFF_BIG;
constexpr size_t OFF_MID = OFF_BIG + (size_t)R * RKLD * 2;
constexpr size_t OFF_MU = OFF_MID + (size_t)R * MIDLD * 2;
static_assert(OFF_MU + (size_t)R * 64 * 4 <= OFF_ZG, "mu overflow");

constexpr size_t W0_FIN_A = 0;
constexpr size_t W0_FOUT_A = W0_FIN_A + (size_t)5632 * 1024;
constexpr size_t W0_FIN_B = W0_FOUT_A + (size_t)1024 * 2816;
constexpr size_t W0_FOUT_B = W0_FIN_B + (size_t)5632 * 1024;
constexpr size_t W0_HIN = W0_FOUT_B + (size_t)1024 * 2816;
constexpr size_t W0_HOUT = W0_HIN + (size_t)HYB_NP * 1024;
constexpr size_t W0_END = W0_HOUT + (size_t)1024 * 1024;
static_assert(W0_END * 2 <= SZ_WB, "w0");
constexpr size_t W1_FIN_A = 0;
constexpr size_t W1_FOUT_A = W1_FIN_A + (size_t)5632 * 1024;
constexpr size_t W1_FIN_B = W1_FOUT_A + (size_t)1024 * 2816;
constexpr size_t W1_FOUT_B = W1_FIN_B + (size_t)5632 * 1024;
constexpr size_t W1_G1 = W1_FOUT_B + (size_t)1024 * 2816;
constexpr size_t W1_W2 = W1_G1 + (size_t)RK_NP * 2048;
constexpr size_t W1_A2 = W1_W2 + (size_t)1024 * 64;
constexpr size_t W1_G2 = W1_A2 + (size_t)1024 * 64;
constexpr size_t W1_WO = W1_G2 + (size_t)1024 * 192;
constexpr size_t W1_END = W1_WO + (size_t)1024 * 1024;
constexpr size_t OUT_W1M = (size_t)R * 1536 * 2;
static_assert(OUT_W1M + (W1_END - W1_G1) * 2 <= (size_t)NB * SEQ * D * 4, "d_out overflow");
static_assert(W1_END * 2 <= SZ_WB, "w1");

struct Params {
  const float *x, *meta, *ffn_norm, *ffn_w_in, *ffn_w_out, *mix_norm, *hyb_w_in, *hyb_fox_bf, *hyb_conv,
      *hyb_a_log, *hyb_dt_bias, *hyb_o_gain, *hyb_w_out, *rwkv_mu, *w_r, *w_k, *w_v, *w0, *w1, *w2, *a0, *a1, *a2,
      *g1, *g2, *k_k, *k_a, *r_k, *ln_w, *ln_b, *w_o, *final_norm;
  float* out;
  char* ws;
};

typedef float f32x2_t __attribute__((ext_vector_type(2)));
typedef __bf16 bf16x2_t __attribute__((ext_vector_type(2)));
__device__ __forceinline__ bf16_t f2bf(float f) {
  const __bf16 h = (__bf16)f;
  return __builtin_bit_cast(unsigned short, h);
}
__device__ __forceinline__ float bf2f(bf16_t h) { return __uint_as_float(((unsigned)h) << 16); }
__device__ __forceinline__ unsigned pack2(float a, float b) {
  const f32x2_t v = {a, b};
  const bf16x2_t r = __builtin_convertvector(v, bf16x2_t);
  return __builtin_bit_cast(unsigned, r);
}
__device__ __forceinline__ float wave_sum(float v) {
#pragma unroll
  for (int o = 32; o > 0; o >>= 1) v += __shfl_xor(v, o);
  return v;
}
__device__ __forceinline__ float sigmoidf_(float x) { return __builtin_amdgcn_rcpf(1.f + __expf(-x)); }
__device__ __forceinline__ float siluf_(float x) { return x * __builtin_amdgcn_rcpf(1.f + __expf(-x)); }
__device__ __forceinline__ float softplusf_(float x) { return x > 20.f ? x : __logf(1.f + __expf(x)); }
__device__ __forceinline__ float softplus_acc(float x) { return x > 20.f ? x : log1pf(__expf(x)); }

__device__ __forceinline__ float dpp_sum16(float v) {
  v += __int_as_float(__builtin_amdgcn_update_dpp(0, __float_as_int(v), 0xB1, 0xf, 0xf, true));
  v += __int_as_float(__builtin_amdgcn_update_dpp(0, __float_as_int(v), 0x4E, 0xf, 0xf, true));
  v += __int_as_float(__builtin_amdgcn_update_dpp(0, __float_as_int(v), 0x141, 0xf, 0xf, true));
  v += __int_as_float(__builtin_amdgcn_update_dpp(0, __float_as_int(v), 0x140, 0xf, 0xf, true));
  return v;
}
__device__ __forceinline__ float wave_sum_fast(float v) {
  v = dpp_sum16(v);
  const int vi = __float_as_int(v);
  return __int_as_float(__builtin_amdgcn_readlane(vi, 0)) + __int_as_float(__builtin_amdgcn_readlane(vi, 16)) +
         __int_as_float(__builtin_amdgcn_readlane(vi, 32)) + __int_as_float(__builtin_amdgcn_readlane(vi, 48));
}
__device__ __forceinline__ float dpp_sum8(float v) {
  v += __int_as_float(__builtin_amdgcn_update_dpp(0, __float_as_int(v), 0xB1, 0xf, 0xf, true));
  v += __int_as_float(__builtin_amdgcn_update_dpp(0, __float_as_int(v), 0x4E, 0xf, 0xf, true));
  v += __int_as_float(__builtin_amdgcn_update_dpp(0, __float_as_int(v), 0x141, 0xf, 0xf, true));
  return v;
}
__device__ __forceinline__ float logsigf_(float x) { return fminf(x, 0.f) - log1pf(__expf(-fabsf(x))); }
__device__ __forceinline__ int otid() { int t = threadIdx.x; asm volatile("" : "+v"(t)); return t; }

struct WJob {
  const float* src; bf16_t* dst; const float* mu;
  int srcld, srccol0, ncols, nrows, r0, dstld, dstk0, ksrc, kjob, perm, smode;
};

__device__ __forceinline__ void wjob_run(const float* jsrc, bf16_t* jdst, int jsrcld, int jsrccol0, int jncols, int jnrows, int jr0,
                                      int jdstld, int jdstk0, int jksrc, int jkjob, int jperm, int jsmode, const float* jmu,
                                      float* tile  , int bid, int nb) {
  WJob j; j.src = jsrc; j.dst = jdst; j.mu = jmu; j.srcld = jsrcld; j.srccol0 = jsrccol0; j.ncols = jncols; j.nrows = jnrows;
  j.r0 = jr0; j.dstld = jdstld; j.dstk0 = jdstk0; j.ksrc = jksrc; j.kjob = jkjob; j.perm = jperm; j.smode = jsmode;
  const int tid = otid();
  const int tn = (j.nrows + 31) >> 5, tk = j.kjob >> 5;
  for (int t = bid; t < tn * tk; t += nb) {
    const int n0 = (t / tk) * 32, k0 = (t % tk) * 32;
    {
      const int tx = tid & 31, ty = tid >> 5;
      const int n = n0 + tx;
      int sc = -1;
      if (n < j.ncols) {
        if (j.perm) { int q = n >> 5, i = n & 31; sc = (i < 16) ? (q * 16 + i) : (DFF + q * 16 + i - 16); }
        else sc = j.srccol0 + n;
      }
#pragma unroll
      for (int i = 0; i < 4; i++) {
        const int k = k0 + ty + 8 * i;
        float v = 0.f;
        if (sc >= 0 && k < j.ksrc) {
          v = j.src[(size_t)k * j.srcld + sc];
          if (j.smode == 1) v *= j.mu[k]; else if (j.smode == 2) v *= (1.f - j.mu[k]);
        }
        tile[(ty + 8 * i) * 33 + tx] = v;
      }
    }
    __syncthreads();
    {
      const int kx = tid & 31, ny = tid >> 5;
#pragma unroll
      for (int i = 0; i < 4; i++) {
        const int n = n0 + ny + 8 * i;
        if (n < j.nrows) j.dst[(size_t)(j.r0 + n) * j.dstld + j.dstk0 + k0 + kx] = f2bf(tile[kx * 33 + ny + 8 * i]);
      }
    }
    __syncthreads();
  }
}

__device__ __forceinline__ WJob mkjob(const float* src, bf16_t* dst, int srcld, int srccol0, int ncols, int nrows, int r0,
                                      int dstld, int dstk0, int ksrc, int kjob, int perm, int smode, const float* mu) {
  WJob j; j.src = src; j.dst = dst; j.mu = mu; j.srcld = srcld; j.srccol0 = srccol0; j.ncols = ncols; j.nrows = nrows;
  j.r0 = r0; j.dstld = dstld; j.dstk0 = dstk0; j.ksrc = ksrc; j.kjob = kjob; j.perm = perm; j.smode = smode; return j;
}

__device__ __forceinline__ void prep_weights(const Params& p, int layer, int which, float* tile, int bid, int nb) {
  bf16_t* wb = (bf16_t*)(p.ws + OFF_WB);
  for (int s = 0; s < 2; s++) {
    if (!((which >> s) & 1)) continue;
    const float* win = p.ffn_w_in + (size_t)(layer * 2 + s) * 1024 * 5632;
    const float* wout = p.ffn_w_out + (size_t)(layer * 2 + s) * 2816 * 1024;
    bf16_t* din = wb + (s ? W0_FIN_B : W0_FIN_A);
    bf16_t* dout = wb + (s ? W0_FOUT_B : W0_FOUT_A);
    wjob_run(win, din, 5632, 0, 5632, 5632, 0, 1024, 0, 1024, 1024, 1, 0, nullptr, tile, bid, nb);
    wjob_run(wout, dout, 1024, 0, 1024, 1024, 0, 2816, 0, 2816, 2816, 0, 0, nullptr, tile, bid, nb);
  }
  if (!(which & 4)) return;
  if (layer == 0) {
    bf16_t* d = wb + W0_HIN;
    const float* s = p.hyb_w_in;
    wjob_run(s, d, 3600, 0, 1536, 1536, 0, 1024, 0, 1024, 1024, 0, 0, nullptr, tile, bid, nb);
    wjob_run(s, d, 3600, 1544, 1536, 1536, 1536, 1024, 0, 1024, 1024, 0, 0, nullptr, tile, bid, nb);
    wjob_run(s, d, 3600, 3088, 512, 512, 3072, 1024, 0, 1024, 1024, 0, 0, nullptr, tile, bid, nb);
    wjob_run(s, d, 3600, 1536, 8, 8, 3584, 1024, 0, 1024, 1024, 0, 0, nullptr, tile, bid, nb);
    wjob_run(s, d, 3600, 3080, 8, 120, 3592, 1024, 0, 1024, 1024, 0, 0, nullptr, tile, bid, nb);
    wjob_run(p.hyb_w_out, wb + W0_HOUT, 1024, 0, 1024, 1024, 0, 1024, 0, 1024, 1024, 0, 0, nullptr, tile, bid, nb);
  } else {
    bf16_t* wm = (bf16_t*)((char*)p.out + OUT_W1M) - W1_G1;
    bf16_t* d = wm + W1_G1;
    const float* mu = p.rwkv_mu;
    for (int half = 0; half < 2; half++) {
      const int sm = half ? 1 : 2;
      const int k0 = half * 1024;
      wjob_run(p.w_r, d, 1024, 0, 1024, 1024, 0, 2048, k0, 1024, 1024, 0, sm, mu + 0 * 1024, tile, bid, nb);
      wjob_run(p.w_k, d, 1024, 0, 1024, 1024, 1024, 2048, k0, 1024, 1024, 0, sm, mu + 2 * 1024, tile, bid, nb);
      wjob_run(p.w_v, d, 1024, 0, 1024, 1024, 2048, 2048, k0, 1024, 1024, 0, sm, mu + 3 * 1024, tile, bid, nb);
      wjob_run(p.w1, d, 64, 0, 64, 64, 3072, 2048, k0, 1024, 1024, 0, sm, mu + 1 * 1024, tile, bid, nb);
      wjob_run(p.a1, d, 64, 0, 64, 64, 3136, 2048, k0, 1024, 1024, 0, sm, mu + 4 * 1024, tile, bid, nb);
      wjob_run(p.g1, d, 160, 0, 160, 256, 3200, 2048, k0, 1024, 1024, 0, sm, mu + 5 * 1024, tile, bid, nb);
    }
    wjob_run(p.w2, wm + W1_W2, 1024, 0, 1024, 1024, 0, 64, 0, 64, 64, 0, 0, nullptr, tile, bid, nb);
    wjob_run(p.a2, wm + W1_A2, 1024, 0, 1024, 1024, 0, 64, 0, 64, 64, 0, 0, nullptr, tile, bid, nb);
    wjob_run(p.g2, wm + W1_G2, 1024, 0, 1024, 1024, 0, 192, 0, 160, 192, 0, 0, nullptr, tile, bid, nb);
    wjob_run(p.w_o, wm + W1_WO, 1024, 0, 1024, 1024, 0, 1024, 0, 1024, 1024, 0, 0, nullptr, tile, bid, nb);
  }
}

template <int MODE>
__device__ __forceinline__ void norm_phase(const Params& p, const float* gain, bf16_t* hn  , int bid, int nb) {
  float* H = (float*)(p.ws + OFF_H);
  const int tid_ = otid(); const int lane = tid_ & 63, wave = tid_ >> 6;
  if (bid == 0) {
    for (int i = threadIdx.x; i < D; i += 256) hn[-D + i] = 0;
  }
  if (MODE == 0) {
    const float4 gq0 = *(const float4*)(gain + lane * 4), gq1 = *(const float4*)(gain + 256 + lane * 4);
    const float4 gq2 = *(const float4*)(gain + 512 + lane * 4), gq3 = *(const float4*)(gain + 768 + lane * 4);
    for (int row = bid * 4 + wave; row < R; row += nb * 8) {
      const int row2 = row + nb * 4;
      const bool has2 = row2 < R;
      const int r2 = has2 ? row2 : row;
      float4 va[4], vb[4];
#pragma unroll
      for (int i = 0; i < 4; i++) {
        va[i] = *(const float4*)(H + (size_t)row * D + i * 256 + lane * 4);
        vb[i] = *(const float4*)(H + (size_t)r2 * D + i * 256 + lane * 4);
      }
      float sa = 0.f, sb = 0.f;
#pragma unroll
      for (int i = 0; i < 4; i++) {
        sa += va[i].x * va[i].x + va[i].y * va[i].y + va[i].z * va[i].z + va[i].w * va[i].w;
        sb += vb[i].x * vb[i].x + vb[i].y * vb[i].y + vb[i].z * vb[i].z + vb[i].w * vb[i].w;
      }
      const float ca = rsqrtf(wave_sum_fast(sa) * (1.f / D) + EPS), cb = rsqrtf(wave_sum_fast(sb) * (1.f / D) + EPS);
      const float4 gq[4] = {gq0, gq1, gq2, gq3};
#pragma unroll
      for (int i = 0; i < 4; i++) {
        uint2 o;
        o.x = pack2(va[i].x * ca * gq[i].x, va[i].y * ca * gq[i].y);
        o.y = pack2(va[i].z * ca * gq[i].z, va[i].w * ca * gq[i].w);
        *(uint2*)(hn + (size_t)row * D + i * 256 + lane * 4) = o;
        if (has2) {
          o.x = pack2(vb[i].x * cb * gq[i].x, vb[i].y * cb * gq[i].y);
          o.y = pack2(vb[i].z * cb * gq[i].z, vb[i].w * cb * gq[i].w);
          *(uint2*)(hn + (size_t)row2 * D + i * 256 + lane * 4) = o;
        }
      }
    }
    return;
  }
  for (int row = bid * 4 + wave; row < R; row += nb * 4) {
    const int b = row / LP, pr = row - b * LP;
    float4 v[4];
    if (MODE == 1) {
      const float* src = nullptr;
      if (pr >= 128) src = p.x + ((size_t)b * SEQ + (pr - 128)) * D;
      else if (pr >= PADR) src = p.meta + (size_t)(pr - PADR) * D;
#pragma unroll
      for (int i = 0; i < 4; i++) {
        v[i] = src ? *(const float4*)(src + i * 256 + lane * 4) : make_float4(0.f, 0.f, 0.f, 0.f);
        *(float4*)(H + (size_t)row * D + i * 256 + lane * 4) = v[i];
      }
    } else {
#pragma unroll
      for (int i = 0; i < 4; i++) v[i] = *(const float4*)(H + (size_t)row * D + i * 256 + lane * 4);
    }
    float ss = 0.f;
#pragma unroll
    for (int i = 0; i < 4; i++) ss += v[i].x * v[i].x + v[i].y * v[i].y + v[i].z * v[i].z + v[i].w * v[i].w;
    ss = wave_sum(ss);
    const float sc = rsqrtf(ss * (1.f / D) + EPS);
#pragma unroll
    for (int i = 0; i < 4; i++) {
      const float4 g = *(const float4*)(gain + i * 256 + lane * 4);
      uint2 o;
      o.x = pack2(v[i].x * sc * g.x, v[i].y * sc * g.y);
      o.y = pack2(v[i].z * sc * g.z, v[i].w * sc * g.w);
      *(uint2*)(hn + (size_t)row * D + i * 256 + lane * 4) = o;
    }
  }
}

__device__ __forceinline__ void final_phase(const Params& p, int bid, int nb) {
  const float* H = (const float*)(p.ws + OFF_H);
  const int tid_ = otid(); const int lane = tid_ & 63, wave = tid_ >> 6;
  float4 g[4];
#pragma unroll
  for (int i = 0; i < 4; i++) g[i] = *(const float4*)(p.final_norm + i * 256 + lane * 4);
  for (int t = bid * 4 + wave; t < NB * SEQ; t += nb * 8) {
    const int t2r = t + nb * 4;
    const bool has2 = t2r < NB * SEQ;
    const int t2 = has2 ? t2r : t;
    const size_t ra = (size_t)(t / SEQ) * LP + 128 + (t % SEQ), rb = (size_t)(t2 / SEQ) * LP + 128 + (t2 % SEQ);
    float4 va[4], vb[4];
#pragma unroll
    for (int i = 0; i < 4; i++) {
      va[i] = *(const float4*)(H + ra * D + i * 256 + lane * 4);
      vb[i] = *(const float4*)(H + rb * D + i * 256 + lane * 4);
    }
    float sa = 0.f, sb = 0.f;
#pragma unroll
    for (int i = 0; i < 4; i++) {
      sa += va[i].x * va[i].x + va[i].y * va[i].y + va[i].z * va[i].z + va[i].w * va[i].w;
      sb += vb[i].x * vb[i].x + vb[i].y * vb[i].y + vb[i].z * vb[i].z + vb[i].w * vb[i].w;
    }
    const float ca = rsqrtf(wave_sum_fast(sa) * (1.f / D) + EPS), cb = rsqrtf(wave_sum_fast(sb) * (1.f / D) + EPS);
#pragma unroll
    for (int i = 0; i < 4; i++) {
      *(float4*)(p.out + (size_t)t * D + i * 256 + lane * 4) =
          make_float4(va[i].x * ca * g[i].x, va[i].y * ca * g[i].y, va[i].z * ca * g[i].z, va[i].w * ca * g[i].w);
      if (has2)
        *(float4*)(p.out + (size_t)t2 * D + i * 256 + lane * 4) =
            make_float4(vb[i].x * cb * g[i].x, vb[i].y * cb * g[i].y, vb[i].z * cb * g[i].z, vb[i].w * cb * g[i].w);
    }
  }
}

__device__ __forceinline__ float xrow16_sum(float x) {
  auto s = __builtin_amdgcn_permlane16_swap(__float_as_uint(x), __float_as_uint(x), false, false);
  x = __uint_as_float(s[0]) + __uint_as_float(s[1]);
  auto t = __builtin_amdgcn_permlane32_swap(__float_as_uint(x), __float_as_uint(x), false, false);
  return __uint_as_float(t[0]) + __uint_as_float(t[1]);
}

enum { EPI_SWIGLU = 0, EPI_RESID = 1, EPI_HYB = 2, EPI_RK1 = 3, EPI_LW = 4, EPI_LA = 5, EPI_LG = 6 };
struct Epi {
  float* f0; bf16_t* b0; bf16_t* b1; const float* v0; const bf16_t* c0; float alpha;
  const bf16_t* y01; const bf16_t* y23; const float* mu; const float* sbp; const float* lnw; const float* lnb;
};

template <int EPI, bool SHIFT, int BM = 128>
__device__ __forceinline__ void gemm_phase(const bf16_t* __restrict__ A, int lda, const bf16_t* __restrict__ Wt, int K, int ntn,
                           const Epi e, bf16_t* smem, int bid, int nb, int tbeg = 0, int tend = 1 << 30) {
  const int tid = otid(), lane = tid & 63, wave = tid >> 6;
  const int wm = wave >> 1, wn = wave & 1;
  const int KT = K >> 6;
  const int lrow = tid >> 3, lchunk = tid & 7;
  const int lsw = ((lchunk ^ ((lrow >> 1) & 7)) << 3);
  const int fr = lane & 15, fq = lane >> 4;
  const int fsw = (fr >> 1) & 7;
  constexpr bool TR = true;
  constexpr int MI = BM / 32;
  constexpr int MTX = R / BM;
  constexpr int MREM = MTX % 8;
  const int band = 8 * ntn, nfull = (MTX / 8) * band;
  for (int it = 0;; it++) {
    int tile;
    if (nb == 512) tile = ((it * 8 + (bid & 7)) << 6) + (bid >> 3); else tile = it * nb + bid;
    tile += tbeg;
    if (tile >= MTX * ntn || tile >= tend) break;
    int mt, nt;
    if (tile < nfull) { const int b_ = tile / band, w_ = tile - b_ * band; nt = w_ >> 3; mt = b_ * 8 + (w_ & 7); }
    else { const int w_ = tile - nfull; nt = w_ / MREM; mt = (MTX / 8) * 8 + (w_ - nt * MREM); }
    const int m0 = mt * BM, n0 = nt * 128;
    f32x4 acc[MI][4];
#pragma unroll
    for (int i = 0; i < MI; i++)
#pragma unroll
      for (int j = 0; j < 4; j++) acc[i][j] = (f32x4){0.f, 0.f, 0.f, 0.f};
    if constexpr (BM == 128) {
    const bf16_t* ap = A + (size_t)(m0 + lrow) * lda + lsw;
    const bf16_t* bp = Wt + (size_t)(n0 + lrow) * K + lsw;
    const size_t a32 = (size_t)32 * lda, b32 = (size_t)32 * K;
    typedef __attribute__((address_space(3))) unsigned lds_u32;
    lds_u32* sbase = (lds_u32*)(smem) + wave * 256;
#define GLDS(AP, KC, KW, OFF)                                                                                   \
  __builtin_amdgcn_global_load_lds((const unsigned*)((AP) + (KC)), sbase + (OFF) / 2, 16, 0, 0);               \
  __builtin_amdgcn_global_load_lds((const unsigned*)((AP) + a32 + (KC)), sbase + ((OFF) + 2048) / 2, 16, 0, 0);   \
  __builtin_amdgcn_global_load_lds((const unsigned*)((AP) + 2 * a32 + (KC)), sbase + ((OFF) + 4096) / 2, 16, 0, 0); \
  __builtin_amdgcn_global_load_lds((const unsigned*)((AP) + 3 * a32 + (KC)), sbase + ((OFF) + 6144) / 2, 16, 0, 0); \
  __builtin_amdgcn_global_load_lds((const unsigned*)(bp + (KW)), sbase + ((OFF) + 8192) / 2, 16, 0, 0);           \
  __builtin_amdgcn_global_load_lds((const unsigned*)(bp + b32 + (KW)), sbase + ((OFF) + 8192 + 2048) / 2, 16, 0, 0); \
  __builtin_amdgcn_global_load_lds((const unsigned*)(bp + 2 * b32 + (KW)), sbase + ((OFF) + 8192 + 4096) / 2, 16, 0, 0); \
  __builtin_amdgcn_global_load_lds((const unsigned*)(bp + 3 * b32 + (KW)), sbase + ((OFF) + 8192 + 6144) / 2, 16, 0, 0);
    GLDS(ap, 0, 0, 0)
    asm volatile("s_waitcnt vmcnt(0)" ::: "memory");
    __syncthreads();
    for (int kt = 0; kt < KT; kt++) {
      const int cur = (kt & 1) * 16384;
      if (kt + 1 < KT) {
        const bf16_t* apx = ap;
        int kc = (kt + 1) * 64;
        if (SHIFT && kc >= 1024) { apx = ap - lda; kc -= 1024; }
        const int nxt = ((kt + 1) & 1) * 16384;
        GLDS(apx, kc, (kt + 1) * 64, nxt)
      }
#pragma unroll
      for (int kk = 0; kk < 2; kk++) {
        bf16x8 af[4], bfr[4];
        const int csw = (((kk * 4 + fq) ^ fsw) << 3);
#pragma unroll
        for (int mi = 0; mi < 4; mi++) af[mi] = *(const bf16x8*)(smem + cur + (wm * 64 + mi * 16 + fr) * 64 + csw);
#pragma unroll
        for (int ni = 0; ni < 4; ni++) bfr[ni] = *(const bf16x8*)(smem + cur + 8192 + (wn * 64 + ni * 16 + fr) * 64 + csw);
#pragma unroll
        for (int mi = 0; mi < 4; mi++)
#pragma unroll
          for (int ni = 0; ni < 4; ni++)
            acc[mi][ni] = TR ? __builtin_amdgcn_mfma_f32_16x16x32_bf16(bfr[ni], af[mi], acc[mi][ni], 0, 0, 0)
                             : __builtin_amdgcn_mfma_f32_16x16x32_bf16(af[mi], bfr[ni], acc[mi][ni], 0, 0, 0);
      }
      asm volatile("s_waitcnt vmcnt(0)" ::: "memory");
      __syncthreads();
    }
#undef GLDS
    } else {
      const bf16_t* ap = A + (size_t)(m0 + lrow) * lda + lsw;
      const bf16_t* bp = Wt + (size_t)(n0 + lrow) * K + lsw;
      const size_t a32 = (size_t)32 * lda, b32 = (size_t)32 * K;
      typedef __attribute__((address_space(3))) unsigned lds_u32;
      lds_u32* sbase = (lds_u32*)(smem) + wave * 256;
      for (int kt = 0; kt < KT; kt++) {
        {
          const bf16_t* apx = ap;
          int kc = kt * 64;
          if (SHIFT && kc >= 1024) { apx = ap - lda; kc -= 1024; }
#pragma unroll
          for (int i = 0; i < 8; i++)
            __builtin_amdgcn_global_load_lds((const unsigned*)(apx + i * a32 + kc), sbase + i * 1024, 16, 0, 0);
#pragma unroll
          for (int i = 0; i < 4; i++)
            __builtin_amdgcn_global_load_lds((const unsigned*)(bp + i * b32 + kt * 64), sbase + 8192 + i * 1024, 16, 0, 0);
        }
        asm volatile("s_waitcnt vmcnt(0)" ::: "memory");
        __syncthreads();
#pragma unroll
        for (int kk = 0; kk < 2; kk++) {
          bf16x8 af[MI], bfr[4];
          const int csw = (((kk * 4 + fq) ^ fsw) << 3);
#pragma unroll
          for (int mi = 0; mi < MI; mi++) af[mi] = *(const bf16x8*)(smem + (wm * 128 + mi * 16 + fr) * 64 + csw);
#pragma unroll
          for (int ni = 0; ni < 4; ni++) bfr[ni] = *(const bf16x8*)(smem + 16384 + (wn * 64 + ni * 16 + fr) * 64 + csw);
#pragma unroll
          for (int mi = 0; mi < MI; mi++)
#pragma unroll
            for (int ni = 0; ni < 4; ni++)
              acc[mi][ni] = __builtin_amdgcn_mfma_f32_16x16x32_bf16(bfr[ni], af[mi], acc[mi][ni], 0, 0, 0);
        }
        __syncthreads();
      }
    }
    if constexpr (!TR) {
    const unsigned rbase = (unsigned)(m0 + wm * 64 + fq * 4);
    const unsigned cbase = (unsigned)(n0 + wn * 64 + fr);
#pragma unroll
    for (int mi = 0; mi < 4; mi++) {
#pragma unroll
      for (int j = 0; j < 4; j++) {
        const unsigned row = rbase + mi * 16 + j;
        if constexpr (EPI == EPI_SWIGLU) {
#pragma unroll
          for (int np = 0; np < 2; np++) {
            const unsigned hc = ((unsigned)(n0 + wn * 64) >> 1) + np * 16 + fr;
            const float g = acc[mi][2 * np][j], u = acc[mi][2 * np + 1][j];
            e.b0[row * (unsigned)DFF + hc] = f2bf(siluf_(g) * u);
          }
        } else {
          const unsigned pr = row % (unsigned)LP;
#pragma unroll
          for (int ni = 0; ni < 4; ni++) {
            const unsigned col = cbase + ni * 16;
            const float a = acc[mi][ni][j];
            if constexpr (EPI == EPI_RESID) {
              if (pr >= PADR) { float* hp = e.f0 + (row * (unsigned)D + col); *hp = *hp + e.alpha * a; }
            } else if constexpr (EPI == EPI_HYB) {
              if (col >= 1024 && col < 1536) {
                const unsigned bb = row / (unsigned)LP;
                e.b1[((bb * 8u + ((col - 1024) >> 6)) * 64u + (col & 63)) * (unsigned)LP + (row - bb * (unsigned)LP)] = f2bf(a);
              } else if (col < ZLD) e.b0[row * (unsigned)ZLD + col] = f2bf(a);
              else if (col < ZLD + 16) e.f0[row * 16u + (col - ZLD)] = a;
            } else if constexpr (EPI == EPI_RK1) {
              if (col < 3072) e.b0[row * (unsigned)RKLD + col] = f2bf(a);
              else if (col < 3136) e.b1[row * (unsigned)MIDLD + (col - 3072)] = f2bf(tanhf(a));
              else if (col < 3200) e.b1[row * (unsigned)MIDLD + (col - 3072)] = f2bf(a);
              else if (col < 3360) e.b1[row * (unsigned)MIDLD + (col - 3072)] = f2bf(sigmoidf_(a));
              else if (col < 3392) e.b1[row * (unsigned)MIDLD + (col - 3072)] = 0;
            } else if constexpr (EPI == EPI_LW) {
              const float wl = -softplusf_(-(e.v0[col] + a)) - 0.5f;
              e.b0[row * (unsigned)D + col] = f2bf(__expf(wl));
            } else if constexpr (EPI == EPI_LA) {
              e.b0[row * (unsigned)D + col] = f2bf(sigmoidf_(e.v0[col] + a));
            } else if constexpr (EPI == EPI_LG) {
              const float yv = bf2f(e.c0[row * (unsigned)RKLD + 2048 + col]);
              e.b0[row * (unsigned)D + col] = (pr >= PADR) ? f2bf(a * yv) : (bf16_t)0;
            }
          }
        }
        __builtin_amdgcn_sched_barrier(0);
      }
    }
    } else {
      const unsigned rb2 = (unsigned)(m0 + wm * (BM / 2) + fr);
      const unsigned cb2 = (unsigned)(n0 + wn * 64 + fq * 4);
#pragma unroll
      for (int mi = 0; mi < MI; mi++) {
        const unsigned row = rb2 + mi * 16;
        const unsigned pr = row % (unsigned)LP;
        if constexpr (EPI == EPI_LG) {
          const unsigned hh = (unsigned)(n0 + wn * 64) >> 6;
          const unsigned bb = row / (unsigned)LP;
          const bf16_t* yb = (bb < 2u) ? (e.y01 + (size_t)bb * LP * D) : (e.y23 + (size_t)(bb - 2u) * LP * D);
          float yv[4][4], vv[4][4];
          float s1 = 0.f;
#pragma unroll
          for (int ni = 0; ni < 4; ni++) {
            const unsigned col = cb2 + ni * 16;
            const uint2 yu = *(const uint2*)(yb + (size_t)pr * D + col);
            const uint2 vu = *(const uint2*)(e.c0 + (row * (unsigned)RKLD + 2048 + col));
            const float m_ = e.mu[row * 64u + hh * 4u + ni];
            yv[ni][0] = bf2f((bf16_t)(yu.x & 0xffff)) + m_; yv[ni][1] = bf2f((bf16_t)(yu.x >> 16)) + m_;
            yv[ni][2] = bf2f((bf16_t)(yu.y & 0xffff)) + m_; yv[ni][3] = bf2f((bf16_t)(yu.y >> 16)) + m_;
            vv[ni][0] = bf2f((bf16_t)(vu.x & 0xffff)); vv[ni][1] = bf2f((bf16_t)(vu.x >> 16));
            vv[ni][2] = bf2f((bf16_t)(vu.y & 0xffff)); vv[ni][3] = bf2f((bf16_t)(vu.y >> 16));
            s1 += (yv[ni][0] + yv[ni][1]) + (yv[ni][2] + yv[ni][3]);
          }
          const float mean = xrow16_sum(s1) * (1.f / 64.f);
          float s2 = 0.f;
#pragma unroll
          for (int ni = 0; ni < 4; ni++)
#pragma unroll
            for (int j = 0; j < 4; j++) { yv[ni][j] -= mean; s2 += yv[ni][j] * yv[ni][j]; }
          const float rstd = rsqrtf(xrow16_sum(s2) * (1.f / 64.f) + 64e-5f);
          const float sb = e.sbp[row * 16u + hh];
#pragma unroll
          for (int ni = 0; ni < 4; ni++) {
            const unsigned col = cb2 + ni * 16;
            const float4 lw = *(const float4*)(e.lnw + col), lb = *(const float4*)(e.lnb + col);
            const f32x4 a = acc[mi][ni];
            uint2 o;
            o.x = pack2(a[0] * (yv[ni][0] * rstd * lw.x + lb.x + sb * vv[ni][0]), a[1] * (yv[ni][1] * rstd * lw.y + lb.y + sb * vv[ni][1]));
            o.y = pack2(a[2] * (yv[ni][2] * rstd * lw.z + lb.z + sb * vv[ni][2]), a[3] * (yv[ni][3] * rstd * lw.w + lb.w + sb * vv[ni][3]));
            if (pr < PADR) { o.x = 0u; o.y = 0u; }
            *(uint2*)(e.b0 + (row * (unsigned)D + col)) = o;
          }
        } else if constexpr (EPI == EPI_SWIGLU) {
#pragma unroll
          for (int np = 0; np < 2; np++) {
            const unsigned hc = ((unsigned)(n0 + wn * 64) >> 1) + np * 16 + fq * 4;
            const f32x4 g = acc[mi][2 * np], u = acc[mi][2 * np + 1];
            uint2 o;
            o.x = pack2(siluf_(g[0]) * u[0], siluf_(g[1]) * u[1]);
            o.y = pack2(siluf_(g[2]) * u[2], siluf_(g[3]) * u[3]);
            *(uint2*)(e.b0 + (row * (unsigned)DFF + hc)) = o;
          }
        } else {
#pragma unroll
          for (int ni = 0; ni < 4; ni++) {
            const unsigned col = cb2 + ni * 16;
            const f32x4 a = acc[mi][ni];
            if constexpr (EPI == EPI_RESID) {
              if (pr >= PADR) {
                float4* hp = (float4*)(e.f0 + (row * (unsigned)D + col));
                float4 hv = *hp;
                hv.x += e.alpha * a[0]; hv.y += e.alpha * a[1]; hv.z += e.alpha * a[2]; hv.w += e.alpha * a[3];
                *hp = hv;
              }
            } else if constexpr (EPI == EPI_HYB) {
              if (col >= 1024 && col < 1536) {
                const unsigned bb = row / (unsigned)LP;
                const unsigned vb_ = ((bb * 8u + ((col - 1024) >> 6)) * 64u + (col & 63)) * (unsigned)LP + (row - bb * (unsigned)LP);
                e.b1[vb_] = f2bf(a[0]); e.b1[vb_ + LP] = f2bf(a[1]); e.b1[vb_ + 2 * LP] = f2bf(a[2]); e.b1[vb_ + 3 * LP] = f2bf(a[3]);
              } else if (col < ZLD) {
                uint2 o; o.x = pack2(a[0], a[1]); o.y = pack2(a[2], a[3]);
                *(uint2*)(e.b0 + (row * (unsigned)ZLD + col)) = o;
              } else if (col < ZLD + 16) {
                *(float4*)(e.f0 + (row * 16u + (col - ZLD))) = make_float4(a[0], a[1], a[2], a[3]);
              }
            } else if constexpr (EPI == EPI_RK1) {
              uint2 o;
              if (col < 3072) {
                o.x = pack2(a[0], a[1]); o.y = pack2(a[2], a[3]);
                *(uint2*)(e.b0 + (row * (unsigned)RKLD + col)) = o;
              } else if (col < 3392) {
                if (col < 3136) { o.x = pack2(tanhf(a[0]), tanhf(a[1])); o.y = pack2(tanhf(a[2]), tanhf(a[3])); }
                else if (col < 3200) { o.x = pack2(a[0], a[1]); o.y = pack2(a[2], a[3]); }
                else if (col < 3360) { o.x = pack2(sigmoidf_(a[0]), sigmoidf_(a[1])); o.y = pack2(sigmoidf_(a[2]), sigmoidf_(a[3])); }
                else { o.x = 0u; o.y = 0u; }
                *(uint2*)(e.b1 + (row * (unsigned)MIDLD + (col - 3072))) = o;
              }
            } else if constexpr (EPI == EPI_LW) {
              const float4 w0v = *(const float4*)(e.v0 + col);
              uint2 o;
              o.x = pack2(__expf(-softplusf_(-(w0v.x + a[0])) - 0.5f), __expf(-softplusf_(-(w0v.y + a[1])) - 0.5f));
              o.y = pack2(__expf(-softplusf_(-(w0v.z + a[2])) - 0.5f), __expf(-softplusf_(-(w0v.w + a[3])) - 0.5f));
              *(uint2*)(e.b0 + (row * (unsigned)D + col)) = o;
            } else if constexpr (EPI == EPI_LA) {
              const float4 a0v = *(const float4*)(e.v0 + col);
              uint2 o;
              o.x = pack2(sigmoidf_(a0v.x + a[0]), sigmoidf_(a0v.y + a[1]));
              o.y = pack2(sigmoidf_(a0v.z + a[2]), sigmoidf_(a0v.w + a[3]));
              *(uint2*)(e.b0 + (row * (unsigned)D + col)) = o;
            } else if constexpr (EPI == EPI_LG) {
              const uint2 yv = *(const uint2*)(e.c0 + (row * (unsigned)RKLD + 2048 + col));
              uint2 o;
              o.x = pack2(a[0] * bf2f((bf16_t)(yv.x & 0xffff)), a[1] * bf2f((bf16_t)(yv.x >> 16)));
              o.y = pack2(a[2] * bf2f((bf16_t)(yv.y & 0xffff)), a[3] * bf2f((bf16_t)(yv.y >> 16)));
              if (pr < PADR) { o.x = 0u; o.y = 0u; }
              *(uint2*)(e.b0 + (row * (unsigned)D + col)) = o;
            }
          }
        }
        __builtin_amdgcn_sched_barrier(0);
      }
    }
  }
}

__device__ __forceinline__ void hyb_prep_phase(const Params& p, float* sm, int bid, int nb) {
  const bf16_t* z = (const bf16_t*)(p.ws + OFF_BIG);
  const float* zg = (const float*)(p.ws + OFF_ZG);
  float* cf = (float*)(p.ws + OFF_CF);
  float* gg = (float*)(p.ws + OFF_GG);
  bf16_t* gp = (bf16_t*)p.out;
  const int tid = otid(); const int lane = tid & 63, wave = tid >> 6;
  for (int item = bid; item < NB * 8; item += nb) {
    const int b = item >> 3, h = item & 7;
    const float bf = p.hyb_fox_bf[h];
    const int p0 = tid * 33;
    float x[33];
    float s = 0.f;
#pragma unroll
    for (int i = 0; i < 33; i++) {
      const int pr = p0 + i;
      float lf = 0.f;
      if (pr >= PADR && pr < LP) lf = logsigf_(zg[((size_t)b * LP + pr) * 16 + h] + bf);
      x[i] = lf; s += lf;
    }
    float inc = s;
#pragma unroll
    for (int o = 1; o < 64; o <<= 1) {
      const float t = __shfl_up(inc, o);
      if (lane >= o) inc += t;
    }
    __syncthreads();
    if (lane == 63) sm[wave] = inc;
    __syncthreads();
    float run = inc - s;
    if (wave > 0) run += sm[0];
    if (wave > 1) run += sm[1];
    if (wave > 2) run += sm[2];
#pragma unroll
    for (int i = 0; i < 33; i++) {
      const int pr = p0 + i;
      run += x[i];
      if (pr < LP) cf[((size_t)b * 8 + h) * LP + pr] = run;
    }
  }
  {
    unsigned* stats = (unsigned*)(p.ws + OFF_STAT);
    for (int it = bid * 4 + wave; it < NB * 8 * 65; it += nb * 4) {
      const int bh = it / 65, seg = it - bh * 65;
      const int b = bh >> 3, h = bh & 7;
      float mq = 0.f, mk = 0.f;
#pragma unroll 4
      for (int g8 = 0; g8 < 16; g8++) {
        const size_t row = (size_t)b * LP + seg * 128 + g8 * 8 + (lane >> 3);
        const uint4 uq = *(const uint4*)(z + row * ZLD + h * 64 + (lane & 7) * 8);
        const uint4 uk = *(const uint4*)(z + row * ZLD + 512 + h * 64 + (lane & 7) * 8);
        const unsigned aq[4] = {uq.x, uq.y, uq.z, uq.w}, ak[4] = {uk.x, uk.y, uk.z, uk.w};
        float sq = 0.f, sk = 0.f;
#pragma unroll
        for (int e = 0; e < 4; e++) {
          const float q0 = bf2f((bf16_t)(aq[e] & 0xffff)), q1 = bf2f((bf16_t)(aq[e] >> 16));
          const float k0 = bf2f((bf16_t)(ak[e] & 0xffff)), k1 = bf2f((bf16_t)(ak[e] >> 16));
          sq += q0 * q0 + q1 * q1; sk += k0 * k0 + k1 * k1;
        }
        mq = fmaxf(mq, dpp_sum8(sq)); mk = fmaxf(mk, dpp_sum8(sk));
      }
#pragma unroll
      for (int o = 32; o > 0; o >>= 1) { mq = fmaxf(mq, __shfl_xor(mq, o)); mk = fmaxf(mk, __shfl_xor(mk, o)); }
      if (lane == 0) { atomicMax(&stats[bh * 2], __float_as_uint(mq)); atomicMax(&stats[bh * 2 + 1], __float_as_uint(mk)); }
    }
  }
  for (int row = bid * 4 + wave; row < R; row += nb * 4) {
    const int pr = row % LP;
    if (pr < PADR) continue;
    float y[12][2];
#pragma unroll
    for (int g = 0; g < 12; g++) {
      const int c = g * 128 + lane * 2;
      float y0 = 0.f, y1 = 0.f;
#pragma unroll
      for (int j = 0; j < 4; j++) {
        const unsigned u = *(const unsigned*)(z + (size_t)(row - 3 + j) * ZLD + 1536 + c);
        const float2 w = *(const float2*)(p.hyb_conv + j * 1536 + c);
        y0 += w.x * bf2f((bf16_t)(u & 0xffff));
        y1 += w.y * bf2f((bf16_t)(u >> 16));
      }
      y[g][0] = siluf_(y0); y[g][1] = siluf_(y1);
    }
#pragma unroll
    for (int g = 0; g < 8; g++) {
      const float n2 = wave_sum_fast(y[g][0] * y[g][0] + y[g][1] * y[g][1]);
      const float sc = rsqrtf(n2 + EPS);
      y[g][0] *= sc; y[g][1] *= sc;
    }
#pragma unroll
    for (int g = 0; g < 12; g++) *(unsigned*)(gp + (size_t)row * 1536 + g * 128 + lane * 2) = pack2(y[g][0], y[g][1]);
    if (lane < 4) {
      const float ga = zg[(size_t)row * 16 + 8 + lane], gb = zg[(size_t)row * 16 + 12 + lane];
      gg[(size_t)row * 8 + lane] = -__expf(p.hyb_a_log[lane]) * softplus_acc(ga + p.hyb_dt_bias[lane]);
      gg[(size_t)row * 8 + 4 + lane] = sigmoidf_(gb);
    }
  }
}

__device__ __forceinline__ void fox_item(const Params& p, int item, float* smf) {
  const int QT = 33;
  const int bh = item / QT, qt = item - bh * QT;
  const int b = bh >> 3, h = bh & 7;
  bf16_t* sm = (bf16_t*)smf;
  float* sC = smf + 8192;
  const bf16_t* z = (const bf16_t*)(p.ws + OFF_BIG);
  const bf16_t* vt = (const bf16_t*)(p.ws + OFF_VT) + (size_t)bh * 64 * LP;
  const float* cf = (const float*)(p.ws + OFF_CF) + (size_t)bh * LP;
  bf16_t* O = (bf16_t*)(p.ws + OFF_O);
  const int tid = otid(), lane = tid & 63, wave = tid >> 6;
  const int fr = lane & 15, g = lane >> 4;
  const int fsw = (fr >> 1) & 7;
  const int q0 = qt * 256, qw0 = q0 + wave * 64;
  const int kdiag = qw0 >> 6;
  const size_t rowb = (size_t)b * LP;
  constexpr float SC2 = 0.18033688011112042f;
  constexpr float LOG2E = 1.4426950408889634f;
  bf16x8 qf[4][2];
#pragma unroll
  for (int qb = 0; qb < 4; qb++) {
    int r = qw0 + qb * 16 + fr; if (r > LP - 1) r = LP - 1;
#pragma unroll
    for (int ks = 0; ks < 2; ks++) qf[qb][ks] = *(const bf16x8*)(z + (rowb + r) * ZLD + h * 64 + ks * 32 + g * 8);
  }
  f32x4 o[4][4];
#pragma unroll
  for (int i = 0; i < 4; i++)
#pragma unroll
    for (int k = 0; k < 4; k++) o[i][k] = (f32x4){0.f, 0.f, 0.f, 0.f};
  float m[4], l[4];
#pragma unroll
  for (int i = 0; i < 4; i++) { m[i] = -1e30f; l[i] = 0.f; }
  int kt_hi = (q0 + 255) >> 6; if (kt_hi > LP / 64 - 1) kt_hi = LP / 64 - 1;
  int kt_lo = 1;
  {
    const unsigned* stats = (const unsigned*)(p.ws + OFF_STAT);
    const float margin = 2.f * 0.125f * sqrtf(__uint_as_float(stats[bh * 2]) * __uint_as_float(stats[bh * 2 + 1]));
    const float cq0 = cf[q0 < PADR ? PADR : q0];
    int found = -1;
#pragma unroll
    for (int base = 0; base < 192; base += 64) {
      const int ktc = base + lane;
      int ke = ktc * 64 + 63; if (ke > LP - 1) ke = LP - 1;
      const bool ok = (ktc >= 1) && (ktc <= kt_hi) && (margin + cq0 - cf[ke] >= -90.f);
      const unsigned long long bal = __ballot(ok);
      if (found < 0 && bal != 0ull) found = base + __ffsll((long long)bal) - 1;
    }
    if (found > 1) kt_lo = found;
  }
  const int lrow = tid >> 3, lchunk = tid & 7;
  const int lsw = ((lchunk ^ ((lrow >> 1) & 7)) << 3);
  uint4 rk0, rk1, rv0, rv1; float rc = 0.f;
#define FOX_LOAD(KT)                                                                         \
  {                                                                                          \
    const bf16_t* kp = z + (rowb + (KT) * 64 + lrow) * ZLD + 512 + h * 64 + lchunk * 8;      \
    rk0 = *(const uint4*)kp; rk1 = *(const uint4*)(kp + (size_t)32 * ZLD);                    \
    const bf16_t* vp = vt + (size_t)lrow * LP + (KT) * 64 + lchunk * 8;                       \
    rv0 = *(const uint4*)vp; rv1 = *(const uint4*)(vp + (size_t)32 * LP);                     \
    if (tid < 64) rc = -cf[(KT) * 64 + tid] * LOG2E;                                          \
  }
#define FOX_STORE(BI)                                                                        \
  {                                                                                          \
    bf16_t* d = sm + (BI) * 8192 + lrow * 64 + lsw;                                          \
    *(uint4*)d = rk0; *(uint4*)(d + 2048) = rk1; *(uint4*)(d + 4096) = rv0; *(uint4*)(d + 4096 + 2048) = rv1; \
    if (tid < 64) sC[(BI) * 64 + tid] = rc;                                                   \
  }
  __syncthreads();
  FOX_LOAD(kt_hi)
  FOX_STORE(0)
  __syncthreads();
  int bi = 0;
  for (int kt = kt_hi; kt >= kt_lo; kt--) {
    if (kt > kt_lo) FOX_LOAD(kt - 1)
    if (kt <= kdiag) {
      const bf16_t* sK = sm + bi * 8192;
      const bf16_t* sV = sK + 4096;
      const float* sCc = sC + bi * 64;
      const bool special = (kt == kdiag) || (kt == 1);
#pragma unroll 1
      for (int ks2 = 0; ks2 < 2; ks2++) {
        f32x4 s[2][4];
#pragma unroll
        for (int kbl = 0; kbl < 2; kbl++)
#pragma unroll
          for (int qb = 0; qb < 4; qb++) s[kbl][qb] = (f32x4){0.f, 0.f, 0.f, 0.f};
#pragma unroll
        for (int kbl = 0; kbl < 2; kbl++) {
#pragma unroll
          for (int ds = 0; ds < 2; ds++) {
            const bf16x8 kf = *(const bf16x8*)(sK + (16 * (2 * ks2 + kbl) + fr) * 64 + (((ds * 4 + g) ^ fsw) << 3));
#pragma unroll
            for (int qb = 0; qb < 4; qb++) s[kbl][qb] = __builtin_amdgcn_mfma_f32_16x16x32_bf16(kf, qf[qb][ds], s[kbl][qb], 0, 0, 0);
          }
        }
        float4 ck[2];
        ck[0] = *(const float4*)(sCc + 16 * (2 * ks2) + 4 * g);
        ck[1] = *(const float4*)(sCc + 16 * (2 * ks2 + 1) + 4 * g);
        float mt[4];
#pragma unroll
        for (int qb = 0; qb < 4; qb++) mt[qb] = -1e30f;
#pragma unroll
        for (int kbl = 0; kbl < 2; kbl++) {
#pragma unroll
          for (int qb = 0; qb < 4; qb++) {
            s[kbl][qb][0] = s[kbl][qb][0] * SC2 + ck[kbl].x;
            s[kbl][qb][1] = s[kbl][qb][1] * SC2 + ck[kbl].y;
            s[kbl][qb][2] = s[kbl][qb][2] * SC2 + ck[kbl].z;
            s[kbl][qb][3] = s[kbl][qb][3] * SC2 + ck[kbl].w;
          }
        }
        if (special) {
#pragma unroll
          for (int kbl = 0; kbl < 2; kbl++)
#pragma unroll
            for (int qb = 0; qb < 4; qb++)
#pragma unroll
              for (int j = 0; j < 4; j++) {
                const int kl = 32 * ks2 + 16 * kbl + 4 * g + j;
                const int ql = 16 * qb + fr;
                bool ok = true;
                if (kt == kdiag) ok = ok && (kl <= ql);
                if (kt == 1) ok = ok && (kl >= 48);
                if (!ok) s[kbl][qb][j] = -1e30f;
              }
        }
#pragma unroll
        for (int kbl = 0; kbl < 2; kbl++)
#pragma unroll
          for (int qb = 0; qb < 4; qb++)
            mt[qb] = fmaxf(mt[qb], fmaxf(fmaxf(s[kbl][qb][0], s[kbl][qb][1]), fmaxf(s[kbl][qb][2], s[kbl][qb][3])));
        bool need = false;
#pragma unroll
        for (int qb = 0; qb < 4; qb++) {
          mt[qb] = fmaxf(mt[qb], __shfl_xor(mt[qb], 16));
          mt[qb] = fmaxf(mt[qb], __shfl_xor(mt[qb], 32));
          need = need || (mt[qb] > m[qb]);
        }
        if (__any(need)) {
#pragma unroll
          for (int qb = 0; qb < 4; qb++) {
            const float mn = fmaxf(m[qb], mt[qb]);
            const float al = __builtin_amdgcn_exp2f(m[qb] - mn);
            m[qb] = mn;
            l[qb] *= al;
#pragma unroll
            for (int db = 0; db < 4; db++) { o[db][qb][0] *= al; o[db][qb][1] *= al; o[db][qb][2] *= al; o[db][qb][3] *= al; }
          }
        }
        bf16x8 pf[4];
#pragma unroll
        for (int qb = 0; qb < 4; qb++) {
          float pv[8];
#pragma unroll
          for (int kbl = 0; kbl < 2; kbl++)
#pragma unroll
            for (int j = 0; j < 4; j++) {
              const float e = __builtin_amdgcn_exp2f(s[kbl][qb][j] - m[qb]);
              pv[kbl * 4 + j] = e;
              l[qb] += e;
            }
          union { bf16x8 v; unsigned u[4]; } cv;
          cv.u[0] = pack2(pv[0], pv[1]); cv.u[1] = pack2(pv[2], pv[3]); cv.u[2] = pack2(pv[4], pv[5]); cv.u[3] = pack2(pv[6], pv[7]);
          pf[qb] = cv.v;
        }
#pragma unroll
        for (int db = 0; db < 4; db++) {
          const int c0 = 4 * ks2 + (g >> 1);
          const bf16_t* vr = sV + (16 * db + fr) * 64 + (g & 1) * 4;
          union { bf16x8 v; uint2 u[2]; } vf;
          vf.u[0] = *(const uint2*)(vr + ((c0 ^ fsw) << 3));
          vf.u[1] = *(const uint2*)(vr + (((c0 + 2) ^ fsw) << 3));
#pragma unroll
          for (int qb = 0; qb < 4; qb++) o[db][qb] = __builtin_amdgcn_mfma_f32_16x16x32_bf16(vf.v, pf[qb], o[db][qb], 0, 0, 0);
        }
      }
    }
    if (kt > kt_lo) FOX_STORE(bi ^ 1)
    __syncthreads();
    bi ^= 1;
  }
#undef FOX_LOAD
#undef FOX_STORE
#pragma unroll
  for (int qb = 0; qb < 4; qb++) {
    float lt = l[qb];
    lt += __shfl_xor(lt, 16);
    lt += __shfl_xor(lt, 32);
    const int r = qw0 + qb * 16 + fr;
    if (r >= PADR && r < LP) {
      const float inv = 1.f / lt;
      bf16_t* op = O + (rowb + r) * D + h * 64 + 4 * g;
#pragma unroll
      for (int db = 0; db < 4; db++) {
        uint2 u;
        u.x = pack2(o[db][qb][0] * inv, o[db][qb][1] * inv);
        u.y = pack2(o[db][qb][2] * inv, o[db][qb][3] * inv);
        *(uint2*)(op + 16 * db) = u;
      }
    }
  }
}


__device__ __forceinline__ void gdn_item(const Params& p, int item, float* sm) {
  const int b = item >> 5, h = (item >> 3) & 3, c0 = (item & 7) * 16;
  const bf16_t* gp = (const bf16_t*)p.out;
  const float* gg = (const float*)(p.ws + OFF_GG);
  bf16_t* O = (bf16_t*)(p.ws + OFF_O);
  constexpr int TC = 16;
  constexpr int BUF = 2 * TC * 128 + TC * 16 + 2 * TC + TC * 16 + TC;
  const int tid = otid(), lane = tid & 63, wave = tid >> 6;
  const int sub = lane & 15, cw = wave * 4 + (lane >> 4);
  const int ltt = tid >> 4, lseg = tid & 15;
  float S[8];
#pragma unroll
  for (int i = 0; i < 8; i++) S[i] = 0.f;
  const size_t rowb = (size_t)b * LP;
  uint4 pq, pk; bf16_t pv; float pg = 0.f, pb = 0.f;
#define GDN_LOAD(T0)                                                                 \
  {                                                                                  \
    const size_t row = rowb + (T0) + ltt;                                            \
    pq = *(const uint4*)(gp + row * 1536 + h * 128 + lseg * 8);                      \
    pk = *(const uint4*)(gp + row * 1536 + 512 + h * 128 + lseg * 8);                \
    pv = gp[row * 1536 + 1024 + h * 128 + c0 + lseg];                                \
    if (tid < TC) { pg = gg[(rowb + (T0) + tid) * 8 + h]; pb = gg[(rowb + (T0) + tid) * 8 + 4 + h]; } \
  }
#define GDN_STORE(BI)                                                                \
  {                                                                                  \
    float* bq = sm + (BI) * BUF + ltt * 128 + lseg * 8;                              \
    float* bk = bq + TC * 128;                                                       \
    *(float4*)(bq) = make_float4(bf2f((bf16_t)(pq.x & 0xffff)), bf2f((bf16_t)(pq.x >> 16)), bf2f((bf16_t)(pq.y & 0xffff)), bf2f((bf16_t)(pq.y >> 16))); \
    *(float4*)(bq + 4) = make_float4(bf2f((bf16_t)(pq.z & 0xffff)), bf2f((bf16_t)(pq.z >> 16)), bf2f((bf16_t)(pq.w & 0xffff)), bf2f((bf16_t)(pq.w >> 16))); \
    *(float4*)(bk) = make_float4(bf2f((bf16_t)(pk.x & 0xffff)), bf2f((bf16_t)(pk.x >> 16)), bf2f((bf16_t)(pk.y & 0xffff)), bf2f((bf16_t)(pk.y >> 16))); \
    *(float4*)(bk + 4) = make_float4(bf2f((bf16_t)(pk.z & 0xffff)), bf2f((bf16_t)(pk.z >> 16)), bf2f((bf16_t)(pk.w & 0xffff)), bf2f((bf16_t)(pk.w >> 16))); \
    sm[(BI) * BUF + 2 * TC * 128 + ltt * 16 + lseg] = bf2f(pv);                       \
    {                                                                                \
      const float4 qa_ = *(const float4*)(bq), qb_ = *(const float4*)(bq + 4);       \
      const float4 ka_ = *(const float4*)(bk), kb_ = *(const float4*)(bk + 4);       \
      const float part_ = (qa_.x * ka_.x + qa_.y * ka_.y + qa_.z * ka_.z + qa_.w * ka_.w) + \
                          (qb_.x * kb_.x + qb_.y * kb_.y + qb_.z * kb_.z + qb_.w * kb_.w);  \
      const float tot_ = dpp_sum16(part_);                                           \
      if (lseg == 0) sm[(BI) * BUF + 2 * TC * 128 + TC * 16 + 2 * TC + TC * 16 + ltt] = tot_; \
    }                                                                                \
    if (tid < TC) { sm[(BI) * BUF + 2 * TC * 128 + TC * 16 + tid] = __expf(pg); sm[(BI) * BUF + 2 * TC * 128 + TC * 16 + TC + tid] = pb; } \
  }
  __syncthreads();
  GDN_LOAD(PADR)
  GDN_STORE(0)
  __syncthreads();
  constexpr int NCH = (LP - PADR) / TC;
  for (int ch = 0; ch < NCH; ch++) {
    const int bi = ch & 1;
    const int t0 = PADR + ch * TC;
    if (ch + 1 < NCH) GDN_LOAD(t0 + TC)
    {
      const float* bq = sm + bi * BUF;
      const float* bk = bq + TC * 128;
      const float* bv = bq + 2 * TC * 128;
      const float* bg = bv + TC * 16;
      float* bo = sm + bi * BUF + 2 * TC * 128 + TC * 16 + 2 * TC;
      float oreg[TC];
#pragma unroll
      for (int t = 0; t < TC; t++) {
        const float4 k0 = *(const float4*)(bk + t * 128 + sub * 4);
        const float4 k1 = *(const float4*)(bk + t * 128 + 64 + sub * 4);
        const float4 q0 = *(const float4*)(bq + t * 128 + sub * 4);
        const float4 q1 = *(const float4*)(bq + t * 128 + 64 + sub * 4);
        const float v = bv[t * 16 + cw];
        const float g = bg[t], be = bg[TC + t];
        const float qk = bo[TC * 16 + t];
        float pa = k0.x * S[0] + k0.y * S[1];
        float pb2 = k0.z * S[2] + k0.w * S[3];
        float qa = q0.x * S[0] + q0.y * S[1];
        float qb2 = q0.z * S[2] + q0.w * S[3];
        pa += k1.x * S[4] + k1.y * S[5];
        pb2 += k1.z * S[6] + k1.w * S[7];
        qa += q1.x * S[4] + q1.y * S[5];
        qb2 += q1.z * S[6] + q1.w * S[7];
        const float ks = dpp_sum16(pa + pb2);
        const float qs = dpp_sum16(qa + qb2);
        const float coef = be * (v - g * ks);
        const float oo = g * qs + coef * qk;
        S[0] = g * S[0] + coef * k0.x; S[1] = g * S[1] + coef * k0.y; S[2] = g * S[2] + coef * k0.z; S[3] = g * S[3] + coef * k0.w;
        S[4] = g * S[4] + coef * k1.x; S[5] = g * S[5] + coef * k1.y; S[6] = g * S[6] + coef * k1.z; S[7] = g * S[7] + coef * k1.w;
        oreg[t] = oo * 0.08838834764831845f;
      }
      if (sub == 0) {
#pragma unroll
        for (int t = 0; t < TC; t++) bo[t * 16 + cw] = oreg[t];
      }
    }
    if (ch + 1 < NCH) GDN_STORE(bi ^ 1)
    __syncthreads();
    {
      const float ov = sm[bi * BUF + 2 * TC * 128 + TC * 16 + 2 * TC + ltt * 16 + lseg];
      O[(rowb + t0 + ltt) * D + 512 + h * 128 + c0 + lseg] = f2bf(ov);
    }
  }
#undef GDN_LOAD
#undef GDN_STORE
  __syncthreads();
}

__device__ __forceinline__ void gdn_norm_phase(const Params& p, int bid, int nb) {
  const bf16_t* z = (const bf16_t*)(p.ws + OFF_BIG);
  bf16_t* O = (bf16_t*)(p.ws + OFF_O);
  const int tid_ = otid(); const int lane = tid_ & 63, wave = tid_ >> 6;
  const float g0 = p.hyb_o_gain[lane * 2], g1 = p.hyb_o_gain[lane * 2 + 1];
  for (int row = bid * 4 + wave; row < R; row += nb * 4) {
    if ((row % LP) < PADR) continue;
    unsigned u[4], gz[4];
#pragma unroll
    for (int h = 0; h < 4; h++) {
      u[h] = *(const unsigned*)(O + (size_t)row * D + 512 + h * 128 + lane * 2);
      gz[h] = *(const unsigned*)(z + (size_t)row * ZLD + 3072 + h * 128 + lane * 2);
    }
#pragma unroll
    for (int h = 0; h < 4; h++) {
      const float o0 = bf2f((bf16_t)(u[h] & 0xffff)), o1 = bf2f((bf16_t)(u[h] >> 16));
      const float ss = wave_sum_fast(o0 * o0 + o1 * o1);
      const float sc = rsqrtf(ss * (1.f / 128.f) + EPS);
      const float z0 = bf2f((bf16_t)(gz[h] & 0xffff)), z1 = bf2f((bf16_t)(gz[h] >> 16));
      *(unsigned*)(O + (size_t)row * D + 512 + h * 128 + lane * 2) = pack2(o0 * sc * g0 * siluf_(z0), o1 * sc * g1 * siluf_(z1));
    }
  }
}

__device__ __forceinline__ void mixer0_phase(const Params& p, float* sm, int bid, int nb) {
  const int nfox = NB * 8 * 33;
  if (nb > 128) {
    if (bid < 128) {
      gdn_item(p, bid, sm);
    } else {
      for (int f = bid - 128; f < nfox; f += nb - 128) {
        const int qt = 32 - f / 32, bh = f % 32;
        fox_item(p, bh * 33 + qt, sm);
      }
    }
  } else {
    for (int it = bid; it < 128 + nfox; it += nb) {
      if (it < 128) gdn_item(p, it, sm);
      else { const int f = it - 128; const int qt = 32 - f / 32, bh = f % 32; fox_item(p, bh * 33 + qt, sm); }
    }
  }
}

__device__ __forceinline__ bf16_t* yraw_ptr(const Params& p, int b) {
  return (b < 2) ? ((bf16_t*)(p.ws + WS_END) + (size_t)b * LP * D) : ((bf16_t*)((char*)p.out + SZ_O) + (size_t)(b - 2) * LP * D);
}

__device__ __forceinline__ void rwkv_item(const Params& p, int item, float* sm) {
  const int bh = item >> 2, rg = item & 3;
  const int b = bh >> 4, h = bh & 15;
  const bf16_t* rkv = (const bf16_t*)(p.ws + OFF_RKV);
  const bf16_t* aa = (const bf16_t*)p.out;
  const bf16_t* wexp = (const bf16_t*)(p.ws + OFF_O);
  float* SB = (float*)(p.ws + OFF_ZG);
  float* MU = (float*)(p.ws + OFF_MU);
  bf16_t* yr = yraw_ptr(p, b);
  constexpr int TC = 16;
  constexpr int BUF = 5 * TC * 64 + TC * 16 + TC + TC * 16;
  const int tid = otid(), lane = tid & 63, wave = tid >> 6;
  const int sub = lane & 15, rowl = wave * 4 + (lane >> 4);
  const int ltt = tid >> 4, lrr = tid & 15;
  const int ch = h * 64 + lane;
  const float kkw = p.k_k[ch], kaw = p.k_a[ch], rkw = p.r_k[ch];
  const size_t rowb = (size_t)b * LP;
  float S0 = 0.f, S1 = 0.f, S2 = 0.f, S3 = 0.f;
  bf16_t pr0, pr1, pr2, pr3, pk0, pk1, pk2, pk3, pa0, pa1, pa2, pa3, pw0, pw1, pw2, pw3, pv;
#define RW_LOAD1(I, PR, PK, PA, PW)                                        \
  {                                                                        \
    const size_t row = rowb + T0_ + 4 * wave + (I);                        \
    PR = rkv[row * RKLD + ch]; PK = rkv[row * RKLD + 1024 + ch];           \
    PA = aa[row * D + ch]; PW = wexp[row * D + ch];                        \
  }
#define RW_LOAD(T0)                                                        \
  {                                                                        \
    const int T0_ = (T0);                                                  \
    RW_LOAD1(0, pr0, pk0, pa0, pw0) RW_LOAD1(1, pr1, pk1, pa1, pw1)        \
    RW_LOAD1(2, pr2, pk2, pa2, pw2) RW_LOAD1(3, pr3, pk3, pa3, pw3)        \
    pv = rkv[(rowb + T0_ + ltt) * RKLD + 2048 + h * 64 + rg * 16 + lrr];   \
  }
#define RW_PREP1(I, PR, PK, PA, PW)                                        \
  {                                                                        \
    const int t = 4 * wave + (I);                                          \
    const float r = bf2f(PR), kr = bf2f(PK), a = bf2f(PA), we = bf2f(PW);  \
    const float kkv = kr * kkw;                                            \
    const float n2 = wave_sum_fast(kkv * kkv);                             \
    const float kk = kkv * rsqrtf(n2 + EPS);                               \
    const float kp = kr * (1.f + (a - 1.f) * kaw);                         \
    const float sb = wave_sum_fast(r * kp * rkw);                          \
    bb_[0 * TC * 64 + t * 64 + lane] = __expf(-we);                        \
    bb_[1 * TC * 64 + t * 64 + lane] = kp;                                 \
    bb_[2 * TC * 64 + t * 64 + lane] = -kk;                                \
    bb_[3 * TC * 64 + t * 64 + lane] = kk * a;                             \
    bb_[4 * TC * 64 + t * 64 + lane] = r;                                  \
    if (lane == 0 && rg == 0) SB[(rowb + TS_ + t) * 16 + h] = sb;          \
  }
#define RW_STORE(BI, TS)                                                   \
  {                                                                        \
    const int TS_ = (TS);                                                  \
    float* bb_ = sm + (BI) * BUF;                                          \
    RW_PREP1(0, pr0, pk0, pa0, pw0) RW_PREP1(1, pr1, pk1, pa1, pw1)        \
    RW_PREP1(2, pr2, pk2, pa2, pw2) RW_PREP1(3, pr3, pk3, pa3, pw3)        \
    bb_[5 * TC * 64 + ltt * 16 + lrr] = bf2f(pv);                          \
  }
  __syncthreads();
  RW_LOAD(PADR)
  RW_STORE(0, PADR)
  __syncthreads();
  constexpr int NCH = (LP - PADR) / TC;
  for (int c = 0; c < NCH; c++) {
    const int bi = c & 1;
    const int t0 = PADR + c * TC;
    if (c + 1 < NCH) RW_LOAD(t0 + TC)
    {
      const float* bw = sm + bi * BUF;
      const float* bv = bw + 5 * TC * 64;
      float* by = sm + bi * BUF + 5 * TC * 64 + TC * 16 + TC;
      float yreg[TC];
#pragma unroll
      for (int t = 0; t < TC; t++) {
        const float4 w4 = *(const float4*)(bw + 0 * TC * 64 + t * 64 + sub * 4);
        const float4 k4 = *(const float4*)(bw + 1 * TC * 64 + t * 64 + sub * 4);
        const float4 a4 = *(const float4*)(bw + 2 * TC * 64 + t * 64 + sub * 4);
        const float4 b4 = *(const float4*)(bw + 3 * TC * 64 + t * 64 + sub * 4);
        const float4 r4 = *(const float4*)(bw + 4 * TC * 64 + t * 64 + sub * 4);
        const float v = bv[t * 16 + rowl];
        const float sa = dpp_sum16((S0 * a4.x + S1 * a4.y) + (S2 * a4.z + S3 * a4.w));
        S0 = S0 * w4.x + (sa * b4.x + v * k4.x);
        S1 = S1 * w4.y + (sa * b4.y + v * k4.y);
        S2 = S2 * w4.z + (sa * b4.z + v * k4.z);
        S3 = S3 * w4.w + (sa * b4.w + v * k4.w);
        const float y = dpp_sum16((S0 * r4.x + S1 * r4.y) + (S2 * r4.z + S3 * r4.w));
        yreg[t] = y;
      }
      if (sub == 0) {
#pragma unroll
        for (int t = 0; t < TC; t++) by[t * 16 + rowl] = yreg[t];
      }
    }
    if (c + 1 < NCH) RW_STORE(bi ^ 1, t0 + TC)
    __syncthreads();
    {
      const float* bb = sm + bi * BUF;
      const float yv = bb[5 * TC * 64 + TC * 16 + TC + ltt * 16 + lrr];
      const float mu = dpp_sum16(yv) * (1.f / 16.f);
      yr[(size_t)(t0 + ltt) * D + h * 64 + rg * 16 + lrr] = f2bf(yv - mu);
      if (lrr == 0) MU[(rowb + t0 + ltt) * 64 + h * 4 + rg] = mu;
    }
  }
#undef RW_LOAD1
#undef RW_LOAD
#undef RW_PREP1
#undef RW_STORE
  __syncthreads();
}

__device__ __forceinline__ void rwkv_phase(const Params& p, float* sm, int bid, int nb) {
  for (int item = bid; item < 256; item += nb) rwkv_item(p, item, sm);
}

__device__ __forceinline__ void rwkv_gn_phase(const Params& p, int bid, int nb) {
  bf16_t* rkv = (bf16_t*)(p.ws + OFF_RKV);
  const float* SB = (const float*)(p.ws + OFF_ZG);
  const float* MU = (const float*)(p.ws + OFF_MU);
  const int tid_ = otid(); const int lane = tid_ & 63, wave = tid_ >> 6;
  for (int it = bid * 4 + wave; it < R * 16; it += nb * 4) {
    const int row = it >> 4, h = it & 15;
    const int b = row / LP, pr = row - b * LP;
    if (pr < PADR) continue;
    const int ch = h * 64 + lane;
    const float y = bf2f(yraw_ptr(p, b)[(size_t)pr * D + ch]) + MU[(size_t)row * 64 + h * 4 + (lane >> 4)];
    const float v = bf2f(rkv[(size_t)row * RKLD + 2048 + ch]);
    const float sb = SB[(size_t)row * 16 + h];
    const float mean = wave_sum(y) * (1.f / 64.f);
    const float dv = y - mean;
    const float var = wave_sum(dv * dv) * (1.f / 64.f);
    rkv[(size_t)row * RKLD + 2048 + ch] = f2bf(dv * rsqrtf(var + 64e-5f) * p.ln_w[ch] + p.ln_b[ch] + sb * v);
  }
}


#define XB_TMO      128
#define XB_XCNT(j)  (256  + 64 * (j))
#define XB_XSUB(j)  (1280 + 64 * (j))
#define XB_XGEN(j)  (2304 + 64 * (j))
#define XB_TOP      3328
#define XB_TOPGEN   3392
#define XCD_BAR_WORDS 3456
#define XB_SPIN_CAP (1u << 18)
__device__ __forceinline__ unsigned xb_ld(unsigned* p) { return __hip_atomic_load(p, __ATOMIC_RELAXED, __HIP_MEMORY_SCOPE_AGENT); }
__device__ __forceinline__ unsigned xb_add(unsigned* p, unsigned v) { return __hip_atomic_fetch_add(p, v, __ATOMIC_RELAXED, __HIP_MEMORY_SCOPE_AGENT); }
__device__ __forceinline__ unsigned xb_xcc_id() { return (unsigned)__builtin_amdgcn_s_getreg((3 << 11) | 20) & 0xFu; }
#define XB_SPIN(cond, bar) do { unsigned _sp = 0; while (cond) { __builtin_amdgcn_s_sleep(1); \
    if ((++_sp & 255u) == 0u) { if (xb_ld(&(bar)[XB_TMO])) break; if (_sp > XB_SPIN_CAP) { atomicAdd(&(bar)[XB_TMO], 1u); break; } } } } while (0)

__device__ __forceinline__ void xcd_barrier_complete(unsigned* bar, unsigned x, unsigned& nloc, unsigned& nx) {
  const unsigned G = gridDim.x;
  unsigned sum, cnt, mine, sp = 0u;
  for (;;) {
    sum = 0u; cnt = 0u; mine = 0u;
#pragma unroll
    for (unsigned j = 0; j < 16; ++j) { const unsigned c = xb_ld(&bar[XB_XCNT(j)]); sum += c; cnt += (c > 0u) ? 1u : 0u; mine = (j == x) ? c : mine; }
    if (sum == G) break;
    __builtin_amdgcn_s_sleep(1);
    if ((++sp & 255u) == 0u) { if (xb_ld(&bar[XB_TMO])) break; if (sp > XB_SPIN_CAP) { atomicAdd(&bar[XB_TMO], 1u); break; } }
  }
  nloc = mine > 0u ? mine : 1u; nx = cnt > 0u ? cnt : 1u;
}

__device__ __forceinline__ void xcd_barrier(unsigned* bar, unsigned x, unsigned& nloc, unsigned& nx) {
  asm volatile("s_waitcnt vmcnt(0)" ::: "memory");
  __syncthreads();
  if (threadIdx.x == 0) {
    __builtin_amdgcn_s_waitcnt(0);
    if (nloc == 0u) xcd_barrier_complete(bar, x, nloc, nx);
    const unsigned old = xb_add(&bar[XB_XSUB(x)], 1u);
    const unsigned gen = old / nloc;
    if (old + 1u == (gen + 1u) * nloc) {
      __builtin_amdgcn_fence(__ATOMIC_RELEASE, "agent");
      asm volatile("s_waitcnt vmcnt(0)" ::: "memory");
      const unsigned og = xb_add(&bar[XB_TOP], 1u);
      const unsigned tg = og / nx;
      if (og + 1u == (tg + 1u) * nx) xb_add(&bar[XB_TOPGEN], 1u);
      else XB_SPIN(xb_ld(&bar[XB_TOPGEN]) == tg, bar);
      __builtin_amdgcn_fence(__ATOMIC_ACQUIRE, "agent");
      xb_add(&bar[XB_XGEN(x)], 1u);
      asm volatile("s_waitcnt vmcnt(0)" ::: "memory");
    } else {
      XB_SPIN(xb_ld(&bar[XB_XGEN(x)]) == gen, bar);
      __builtin_amdgcn_fence(__ATOMIC_ACQUIRE, "agent");
      asm volatile("s_waitcnt vmcnt(0)" ::: "memory");
    }
  }
  __syncthreads();
}

constexpr int NPHASE = 25;
constexpr int LDS_BYTES = 65536;

__device__ __forceinline__ void run_phase(const Params& p, int ph, char* smraw, int bid, int nb) {
  bf16_t* smb = (bf16_t*)smraw;
  float* smf = (float*)smraw;
  bf16_t* wb = (bf16_t*)(p.ws + OFF_WB);
  bf16_t* wm = (bf16_t*)((char*)p.out + OUT_W1M) - W1_G1;
  float* H = (float*)(p.ws + OFF_H);
  bf16_t* hn = (bf16_t*)p.out + D;
  bf16_t* big = (bf16_t*)(p.ws + OFF_BIG);
  bf16_t* obuf = (bf16_t*)(p.ws + OFF_O);
  bf16_t* mid = (bf16_t*)(p.ws + OFF_MID);
  Epi e; e.f0 = nullptr; e.b0 = nullptr; e.b1 = nullptr; e.v0 = nullptr; e.c0 = nullptr; e.alpha = 0.f;
  e.y01 = nullptr; e.y23 = nullptr; e.mu = nullptr; e.sbp = nullptr; e.lnw = nullptr; e.lnb = nullptr;
  int kind = 7;
  const bf16_t* A = nullptr; int lda = 0; const bf16_t* W = nullptr; int K = 0; int ntn = 0;
  const float* gain = nullptr; int layer = 0;
  switch (ph) {
    case 0: kind = 0; layer = 0; gain = p.ffn_norm + 0 * D; break;
    case 1: kind = 1; W = wb + W0_FIN_A; break;
    case 2: kind = 2; A = big; lda = DFF; W = wb + W0_FOUT_A; K = DFF; e.alpha = 0.5f; break;
    case 3: kind = 3; gain = p.mix_norm + 0 * D; break;
    case 4: kind = 4; break;
    case 5: kind = 5; break;
    case 6: kind = 6; break;
    case 7: kind = 13; break;
    case 8: kind = 2; A = obuf; lda = D; W = wb + W0_HOUT; K = 1024; e.alpha = 1.f; break;
    case 9: kind = 3; gain = p.ffn_norm + 1 * D; break;
    case 10: kind = 1; W = wb + W0_FIN_B; break;
    case 11: kind = 2; A = big; lda = DFF; W = wb + W0_FOUT_B; K = DFF; e.alpha = 0.5f; break;
    case 12: kind = 0; layer = 1; gain = p.ffn_norm + 2 * D; break;
    case 13: kind = 1; W = wb + W1_FIN_A; break;
    case 14: kind = 2; A = big; lda = DFF; W = wb + W1_FOUT_A; K = DFF; e.alpha = 0.5f; break;
    case 15: kind = 3; gain = p.mix_norm + 1 * D; break;
    case 16: kind = 8; break;
    case 17: kind = 9; break;
    case 18: kind = 10; break;
    case 19: kind = 11; break;
    case 20: kind = 2; A = obuf; lda = D; W = wm + W1_WO; K = 1024; e.alpha = 1.f; break;
    case 21: kind = 3; gain = p.ffn_norm + 3 * D; break;
    case 22: kind = 1; W = wb + W1_FIN_B; break;
    case 23: kind = 2; A = big; lda = DFF; W = wb + W1_FOUT_B; K = DFF; e.alpha = 0.5f; break;
    case 24: kind = 12; break;
    default: break;
  }
  bool prep_after = false;
  if (kind == 6) {
    const int rk = ((const int*)(p.ws + OFF_RANK))[bid];
    const int np = (int)*(const unsigned*)(p.ws + OFF_NPRIM);
    if (rk < 0) {
      const int idle_rank = ((const int*)(p.ws + OFF_RANK))[512 + bid];
      prep_weights(p, 1, 1 | 4, smf, idle_rank, nb - np);
      return;
    }
    prep_after = (np >= nb);
    bid = rk; nb = np;
  }
  switch (kind) {
    case 0:
      if (layer == 0) prep_weights(p, 0, 7, smf, bid, nb);
      if (layer == 0) norm_phase<1>(p, gain, hn, bid, nb); else norm_phase<0>(p, gain, hn, bid, nb);
      break;
    case 1: e.b0 = big; gemm_phase<EPI_SWIGLU, false, 256>(hn, D, W, 1024, 44, e, smb, bid, nb); break;
    case 2: e.f0 = H;
      if (nb == 512) {
        gemm_phase<EPI_RESID, false, 256>(A, lda, W, K, 8, e, smb, bid, nb, 0, 1024);
        gemm_phase<EPI_RESID, false>(A, lda, W, K, 8, e, smb, bid, nb, 2048, 2080);
      } else gemm_phase<EPI_RESID, false>(A, lda, W, K, 8, e, smb, bid, nb);
      break;
    case 3: norm_phase<0>(p, gain, hn, bid, nb); break;
    case 4: e.b0 = big; e.f0 = (float*)(p.ws + OFF_ZG); e.b1 = (bf16_t*)(p.ws + OFF_VT);
      gemm_phase<EPI_HYB, false, 256>(hn, D, wb + W0_HIN, 1024, HYB_NP / 128, e, smb, bid, nb); break;
    case 5: hyb_prep_phase(p, smf, bid, nb); break;
#ifndef SKIP_MIX
    case 6: mixer0_phase(p, smf, bid, nb); if (prep_after) { __syncthreads(); prep_weights(p, 1, 1 | 4, smf, bid, nb); } break;
#endif
    case 8: e.b0 = (bf16_t*)(p.ws + OFF_RKV); e.b1 = mid;
      gemm_phase<EPI_RK1, true, 256>(hn, D, wm + W1_G1, 2048, RK_NP / 128, e, smb, bid, nb); break;
    case 9:
      e.b0 = obuf; e.v0 = p.w0;
      gemm_phase<EPI_LW, false>(mid, MIDLD, wm + W1_W2, 64, 8, e, smb, bid, nb);
      e.b0 = (bf16_t*)p.out; e.v0 = p.a0;
      gemm_phase<EPI_LA, false>(mid + 64, MIDLD, wm + W1_A2, 64, 8, e, smb, bid, nb);
      break;
#ifndef SKIP_RWKV
    case 10:
      if (nb == 512 && bid >= 256) prep_weights(p, 1, 2, smf, bid - 256, 256);
      else { if (nb != 512) prep_weights(p, 1, 2, smf, bid, nb); rwkv_phase(p, smf, bid, nb); }
      break;
#endif
    case 11: e.b0 = obuf; e.c0 = (const bf16_t*)(p.ws + OFF_RKV);
      e.y01 = (const bf16_t*)(p.ws + WS_END); e.y23 = (const bf16_t*)((const char*)p.out + SZ_O); e.mu = (const float*)(p.ws + OFF_MU);
      e.sbp = (const float*)(p.ws + OFF_ZG); e.lnw = p.ln_w; e.lnb = p.ln_b;
      gemm_phase<EPI_LG, false>(mid + 128, MIDLD, wm + W1_G2, 192, 8, e, smb, bid, nb); break;
    case 12: final_phase(p, bid, nb); break;
    case 13: gdn_norm_phase(p, bid, nb); break;
    case 14: rwkv_gn_phase(p, bid, nb); break;
    default: break;
  }
}

#if MEGA
__global__ void __launch_bounds__(256, 2) mega_kernel(Params p) {
  __shared__ __attribute__((aligned(16))) char smraw[LDS_BYTES];
  cg::grid_group grid = cg::this_grid();
  unsigned* bar = (unsigned*)(p.ws + OFF_BAR);
  const unsigned xcc = xb_xcc_id();
  unsigned nloc = 0u, nx = 0u;
  if (threadIdx.x == 0) {
    (void)xb_add(&bar[XB_XCNT(xcc)], 1u);
    const unsigned hwid = (unsigned)__builtin_amdgcn_s_getreg((7 << 11) | (8 << 6) | 4);
    const unsigned key = (xcc << 8) | (hwid & 0xFFu);
    unsigned* cucnt = (unsigned*)(p.ws + OFF_CUCNT);
    int rk = -1;
    if (xb_add(&cucnt[key], 1u) == 0u) rk = (int)xb_add((unsigned*)(p.ws + OFF_NPRIM), 1u);
    ((int*)(p.ws + OFF_RANK))[blockIdx.x] = rk;
    ((int*)(p.ws + OFF_RANK))[512 + blockIdx.x] = (rk < 0) ? (int)xb_add((unsigned*)(p.ws + OFF_NPRIM) + 16, 1u) : -1;
  }
  for (int ph = 0; ph < NPHASE; ph++) {
    run_phase(p, ph, smraw, blockIdx.x, gridDim.x);
    if (ph + 1 < NPHASE) {
      if (ph == 0) grid.sync();
      else xcd_barrier(bar, xcc, nloc, nx);
    }
  }
}
#else
template <int PH>
__global__ void __launch_bounds__(256) phase_kernel(Params p) {
  __shared__ __attribute__((aligned(16))) char smraw[LDS_BYTES];
  run_phase(p, PH, smraw, blockIdx.x, gridDim.x);
}
template <int PH>
static void launch_all(const Params& p, hipStream_t stream) {
  if constexpr (PH < NPHASE) {
    if (PH != 7) phase_kernel<PH><<<512, 256, 0, stream>>>(p);
    launch_all<PH + 1>(p, stream);
  }
}
#endif

extern "C" void kernel_launch(void* const* d_in, const int* in_sizes, int n_in, void* d_out, int out_size, void* d_ws,
                              size_t ws_size, hipStream_t stream) {
  Params p{};
  const float** pp = (const float**)&p;
  for (int i = 0; i < 32; i++) pp[i] = (const float*)d_in[i];
  p.out = (float*)d_out;
  p.ws = (char*)d_ws;
#if MEGA
  static int grid_blocks = 0;
  if (!grid_blocks) {
    int dev = 0, cus = 0, per_cu = 0;
    hipGetDevice(&dev);
    hipDeviceGetAttribute(&cus, hipDeviceAttributeMultiprocessorCount, dev);
    hipOccupancyMaxActiveBlocksPerMultiprocessor(&per_cu, mega_kernel, 256, 0);
    if (per_cu > 2) per_cu = 2;
    if (per_cu < 1) per_cu = 1;
    grid_blocks = cus * per_cu;
  }
  hipMemsetAsync((char*)d_ws + OFF_BAR, 0, SZ_SYNC, stream);
  void* args[] = {&p};
  hipError_t err = hipLaunchCooperativeKernel((void*)mega_kernel, dim3(grid_blocks), dim3(256), args, 0, stream);
  if (err != hipSuccess) fprintf(stderr, "cooperative launch failed: %s (grid %d)\n", hipGetErrorString(err), grid_blocks);
#else
  launch_all<0>(p, stream);
#endif
}
```

```cpp
#include <hip/hip_runtime.h>
#include <hip/hip_cooperative_groups.h>
#include <stdint.h>
#include <stdio.h>
namespace cg = cooperative_groups;

#ifndef MEGA
#define MEGA 1
#endif

typedef unsigned short bf16_t;
using bf16x8 = __attribute__((ext_vector_type(8))) short;
using f32x4 = __attribute__((ext_vector_type(4))) float;

constexpr int NB = 4;
constexpr int SEQ = 8192;
constexpr int NMETA = 16;
constexpr int PADR = 112;
constexpr int LP = 8320;
constexpr int R = NB * LP;
constexpr int D = 1024;
constexpr int DFF = 2816;
constexpr int MT = R / 128;
constexpr float EPS = 1e-6f;

constexpr int ZLD = 3584;
constexpr int HYB_NP = 3712;
constexpr int RK_NP = 3456;
constexpr int RKLD = 3072;
constexpr int MIDLD = 320;

constexpr size_t OFF_H = 0;
constexpr size_t SZ_H = (size_t)R * D * 4;
constexpr size_t OFF_WB = OFF_H + SZ_H;
constexpr size_t SZ_WB = (size_t)52 << 20;
constexpr size_t OFF_BIG = OFF_WB + SZ_WB;
constexpr size_t SZ_BIG = (size_t)R * ZLD * 2;
constexpr size_t OFF_ZG = OFF_BIG + SZ_BIG;
constexpr size_t SZ_ZG = (size_t)R * 16 * 4;
constexpr size_t OFF_CF = OFF_ZG + SZ_ZG;
constexpr size_t SZ_CF = (size_t)NB * 8 * LP * 4;
constexpr size_t OFF_GG = OFF_CF + SZ_CF;
constexpr size_t SZ_GG = (size_t)R * 8 * 4;
constexpr size_t OFF_O = OFF_GG + SZ_GG;
constexpr size_t SZ_O = (size_t)R * D * 2;
constexpr size_t WS_END = OFF_O + SZ_O;
constexpr size_t OFF_VT = WS_END;
constexpr size_t SZ_VT = (size_t)NB * 8 * 64 * LP * 2;
constexpr size_t OFF_BAR = OFF_VT + SZ_VT;
constexpr size_t OFF_STAT = OFF_BAR + 16384;
constexpr size_t OFF_CUCNT = OFF_STAT + 256;
constexpr size_t OFF_NPRIM = OFF_CUCNT + 16384;
constexpr size_t OFF_RANK = OFF_NPRIM + 256;
constexpr size_t SZ_SYNC = 16384 + 256 + 16384 + 256 + 4096;
static_assert(OFF_BAR + SZ_SYNC <= ((size_t)512 << 20), "ws overflow");
constexpr size_t OFF_RKV = OFF_BIG;
constexpr size_t OFF_MID = OFF_BIG + (size_t)R * RKLD * 2;
constexpr size_t OFF_MU = OFF_MID + (size_t)R * MIDLD * 2;
static_assert(OFF_MU + (size_t)R * 64 * 4 <= OFF_ZG, "mu overflow");

constexpr size_t W0_FIN_A = 0;
constexpr size_t W0_FOUT_A = W0_FIN_A + (size_t)5632 * 1024;
constexpr size_t W0_FIN_B = W0_FOUT_A + (size_t)1024 * 2816;
constexpr size_t W0_FOUT_B = W0_FIN_B + (size_t)5632 * 1024;
constexpr size_t W0_HIN = W0_FOUT_B + (size_t)1024 * 2816;
constexpr size_t W0_HOUT = W0_HIN + (size_t)HYB_NP * 1024;
constexpr size_t W0_END = W0_HOUT + (size_t)1024 * 1024;
static_assert(W0_END * 2 <= SZ_WB, "w0");
constexpr size_t W1_FIN_A = 0;
constexpr size_t W1_FOUT_A = W1_FIN_A + (size_t)5632 * 1024;
constexpr size_t W1_FIN_B = W1_FOUT_A + (size_t)1024 * 2816;
constexpr size_t W1_FOUT_B = W1_FIN_B + (size_t)5632 * 1024;
constexpr size_t W1_G1 = W1_FOUT_B + (size_t)1024 * 2816;
constexpr size_t W1_W2 = W1_G1 + (size_t)RK_NP * 2048;
constexpr size_t W1_A2 = W1_W2 + (size_t)1024 * 64;
constexpr size_t W1_G2 = W1_A2 + (size_t)1024 * 64;
constexpr size_t W1_WO = W1_G2 + (size_t)1024 * 192;
constexpr size_t W1_END = W1_WO + (size_t)1024 * 1024;
constexpr size_t OUT_W1M = (size_t)R * 1536 * 2;
static_assert(OUT_W1M + (W1_END - W1_G1) * 2 <= (size_t)NB * SEQ * D * 4, "d_out overflow");
static_assert(W1_END * 2 <= SZ_WB, "w1");

struct Params {
  const float *x, *meta, *ffn_norm, *ffn_w_in, *ffn_w_out, *mix_norm, *hyb_w_in, *hyb_fox_bf, *hyb_conv,
      *hyb_a_log, *hyb_dt_bias, *hyb_o_gain, *hyb_w_out, *rwkv_mu, *w_r, *w_k, *w_v, *w0, *w1, *w2, *a0, *a1, *a2,
      *g1, *g2, *k_k, *k_a, *r_k, *ln_w, *ln_b, *w_o, *final_norm;
  float* out;
  char* ws;
};

typedef float f32x2_t __attribute__((ext_vector_type(2)));
typedef __bf16 bf16x2_t __attribute__((ext_vector_type(2)));
__device__ __forceinline__ bf16_t f2bf(float f) {
  const __bf16 h = (__bf16)f;
  return __builtin_bit_cast(unsigned short, h);
}
__device__ __forceinline__ float bf2f(bf16_t h) { return __uint_as_float(((unsigned)h) << 16); }
__device__ __forceinline__ unsigned pack2(float a, float b) {
  const f32x2_t v = {a, b};
  const bf16x2_t r = __builtin_convertvector(v, bf16x2_t);
  return __builtin_bit_cast(unsigned, r);
}
__device__ __forceinline__ float wave_sum(float v) {
#pragma unroll
  for (int o = 32; o > 0; o >>= 1) v += __shfl_xor(v, o);
  return v;
}
__device__ __forceinline__ float sigmoidf_(float x) { return __builtin_amdgcn_rcpf(1.f + __expf(-x)); }
__device__ __forceinline__ float siluf_(float x) { return x * __builtin_amdgcn_rcpf(1.f + __expf(-x)); }
__device__ __forceinline__ float softplusf_(float x) { return x > 20.f ? x : __logf(1.f + __expf(x)); }
__device__ __forceinline__ float softplus_acc(float x) { return x > 20.f ? x : log1pf(__expf(x)); }

__device__ __forceinline__ float dpp_sum16(float v) {
  v += __int_as_float(__builtin_amdgcn_update_dpp(0, __float_as_int(v), 0xB1, 0xf, 0xf, true));
  v += __int_as_float(__builtin_amdgcn_update_dpp(0, __float_as_int(v), 0x4E, 0xf, 0xf, true));
  v += __int_as_float(__builtin_amdgcn_update_dpp(0, __float_as_int(v), 0x141, 0xf, 0xf, true));
  v += __int_as_float(__builtin_amdgcn_update_dpp(0, __float_as_int(v), 0x140, 0xf, 0xf, true));
  return v;
}
__device__ __forceinline__ float wave_sum_fast(float v) {
  v = dpp_sum16(v);
  const int vi = __float_as_int(v);
  return __int_as_float(__builtin_amdgcn_readlane(vi, 0)) + __int_as_float(__builtin_amdgcn_readlane(vi, 16)) +
         __int_as_float(__builtin_amdgcn_readlane(vi, 32)) + __int_as_float(__builtin_amdgcn_readlane(vi, 48));
}
__device__ __forceinline__ float dpp_sum8(float v) {
  v += __int_as_float(__builtin_amdgcn_update_dpp(0, __float_as_int(v), 0xB1, 0xf, 0xf, true));
  v += __int_as_float(__builtin_amdgcn_update_dpp(0, __float_as_int(v), 0x4E, 0xf, 0xf, true));
  v += __int_as_float(__builtin_amdgcn_update_dpp(0, __float_as_int(v), 0x141, 0xf, 0xf, true));
  return v;
}
__device__ __forceinline__ float logsigf_(float x) { return fminf(x, 0.f) - log1pf(__expf(-fabsf(x))); }
__device__ __forceinline__ int otid() { int t = threadIdx.x; asm volatile("" : "+v"(t)); return t; }

struct WJob {
  const float* src; bf16_t* dst; const float* mu;
  int srcld, srccol0, ncols, nrows, r0, dstld, dstk0, ksrc, kjob, perm, smode;
};

__device__ __forceinline__ void wjob_run(const float* jsrc, bf16_t* jdst, int jsrcld, int jsrccol0, int jncols, int jnrows, int jr0,
                                      int jdstld, int jdstk0, int jksrc, int jkjob, int jperm, int jsmode, const float* jmu,
                                      float* tile  , int bid, int nb) {
  WJob j; j.src = jsrc; j.dst = jdst; j.mu = jmu; j.srcld = jsrcld; j.srccol0 = jsrccol0; j.ncols = jncols; j.nrows = jnrows;
  j.r0 = jr0; j.dstld = jdstld; j.dstk0 = jdstk0; j.ksrc = jksrc; j.kjob = jkjob; j.perm = jperm; j.smode = jsmode;
  const int tid = otid();
  const int tn = (j.nrows + 31) >> 5, tk = j.kjob >> 5;
  for (int t = bid; t < tn * tk; t += nb) {
    const int n0 = (t / tk) * 32, k0 = (t % tk) * 32;
    {
      const int tx = tid & 31, ty = tid >> 5;
      const int n = n0 + tx;
      int sc = -1;
      if (n < j.ncols) {
        if (j.perm) { int q = n >> 5, i = n & 31; sc = (i < 16) ? (q * 16 + i) : (DFF + q * 16 + i - 16); }
        else sc = j.srccol0 + n;
      }
#pragma unroll
      for (int i = 0; i < 4; i++) {
        const int k = k0 + ty + 8 * i;
        float v = 0.f;
        if (sc >= 0 && k < j.ksrc) {
          v = j.src[(size_t)k * j.srcld + sc];
          if (j.smode == 1) v *= j.mu[k]; else if (j.smode == 2) v *= (1.f - j.mu[k]);
        }
        tile[(ty + 8 * i) * 33 + tx] = v;
      }
    }
    __syncthreads();
    {
      const int kx = tid & 31, ny = tid >> 5;
#pragma unroll
      for (int i = 0; i < 4; i++) {
        const int n = n0 + ny + 8 * i;
        if (n < j.nrows) j.dst[(size_t)(j.r0 + n) * j.dstld + j.dstk0 + k0 + kx] = f2bf(tile[kx * 33 + ny + 8 * i]);
      }
    }
    __syncthreads();
  }
}

__device__ __forceinline__ WJob mkjob(const float* src, bf16_t* dst, int srcld, int srccol0, int ncols, int nrows, int r0,
                                      int dstld, int dstk0, int ksrc, int kjob, int perm, int smode, const float* mu) {
  WJob j; j.src = src; j.dst = dst; j.mu = mu; j.srcld = srcld; j.srccol0 = srccol0; j.ncols = ncols; j.nrows = nrows;
  j.r0 = r0; j.dstld = dstld; j.dstk0 = dstk0; j.ksrc = ksrc; j.kjob = kjob; j.perm = perm; j.smode = smode; return j;
}

__device__ __forceinline__ void prep_weights(const Params& p, int layer, int which, float* tile, int bid, int nb) {
  bf16_t* wb = (bf16_t*)(p.ws + OFF_WB);
  for (int s = 0; s < 2; s++) {
    if (!((which >> s) & 1)) continue;
    const float* win = p.ffn_w_in + (size_t)(layer * 2 + s) * 1024 * 5632;
    const float* wout = p.ffn_w_out + (size_t)(layer * 2 + s) * 2816 * 1024;
    bf16_t* din = wb + (s ? W0_FIN_B : W0_FIN_A);
    bf16_t* dout = wb + (s ? W0_FOUT_B : W0_FOUT_A);
    wjob_run(win, din, 5632, 0, 5632, 5632, 0, 1024, 0, 1024, 1024, 1, 0, nullptr, tile, bid, nb);
    wjob_run(wout, dout, 1024, 0, 1024, 1024, 0, 2816, 0, 2816, 2816, 0, 0, nullptr, tile, bid, nb);
  }
  if (!(which & 4)) return;
  if (layer == 0) {
    bf16_t* d = wb + W0_HIN;
    const float* s = p.hyb_w_in;
    wjob_run(s, d, 3600, 0, 1536, 1536, 0, 1024, 0, 1024, 1024, 0, 0, nullptr, tile, bid, nb);
    wjob_run(s, d, 3600, 1544, 1536, 1536, 1536, 1024, 0, 1024, 1024, 0, 0, nullptr, tile, bid, nb);
    wjob_run(s, d, 3600, 3088, 512, 512, 3072, 1024, 0, 1024, 1024, 0, 0, nullptr, tile, bid, nb);
    wjob_run(s, d, 3600, 1536, 8, 8, 3584, 1024, 0, 1024, 1024, 0, 0, nullptr, tile, bid, nb);
    wjob_run(s, d, 3600, 3080, 8, 120, 3592, 1024, 0, 1024, 1024, 0, 0, nullptr, tile, bid, nb);
    wjob_run(p.hyb_w_out, wb + W0_HOUT, 1024, 0, 1024, 1024, 0, 1024, 0, 1024, 1024, 0, 0, nullptr, tile, bid, nb);
  } else {
    bf16_t* wm = (bf16_t*)((char*)p.out + OUT_W1M) - W1_G1;
    bf16_t* d = wm + W1_G1;
    const float* mu = p.rwkv_mu;
    for (int half = 0; half < 2; half++) {
      const int sm = half ? 1 : 2;
      const int k0 = half * 1024;
      wjob_run(p.w_r, d, 1024, 0, 1024, 1024, 0, 2048, k0, 1024, 1024, 0, sm, mu + 0 * 1024, tile, bid, nb);
      wjob_run(p.w_k, d, 1024, 0, 1024, 1024, 1024, 2048, k0, 1024, 1024, 0, sm, mu + 2 * 1024, tile, bid, nb);
      wjob_run(p.w_v, d, 1024, 0, 1024, 1024, 2048, 2048, k0, 1024, 1024, 0, sm, mu + 3 * 1024, tile, bid, nb);
      wjob_run(p.w1, d, 64, 0, 64, 64, 3072, 2048, k0, 1024, 1024, 0, sm, mu + 1 * 1024, tile, bid, nb);
      wjob_run(p.a1, d, 64, 0, 64, 64, 3136, 2048, k0, 1024, 1024, 0, sm, mu + 4 * 1024, tile, bid, nb);
      wjob_run(p.g1, d, 160, 0, 160, 256, 3200, 2048, k0, 1024, 1024, 0, sm, mu + 5 * 1024, tile, bid, nb);
    }
    wjob_run(p.w2, wm + W1_W2, 1024, 0, 1024, 1024, 0, 64, 0, 64, 64, 0, 0, nullptr, tile, bid, nb);
    wjob_run(p.a2, wm + W1_A2, 1024, 0, 1024, 1024, 0, 64, 0, 64, 64, 0, 0, nullptr, tile, bid, nb);
    wjob_run(p.g2, wm + W1_G2, 1024, 0, 1024, 1024, 0, 192, 0, 160, 192, 0, 0, nullptr, tile, bid, nb);
    wjob_run(p.w_o, wm + W1_WO, 1024, 0, 1024, 1024, 0, 1024, 0, 1024, 1024, 0, 0, nullptr, tile, bid, nb);
  }
}

template <int MODE>
__device__ __forceinline__ void norm_phase(const Params& p, const float* gain, bf16_t* hn  , int bid, int nb) {
  float* H = (float*)(p.ws + OFF_H);
  const int tid_ = otid(); const int lane = tid_ & 63, wave = tid_ >> 6;
  if (bid == 0) {
    for (int i = threadIdx.x; i < D; i += 256) hn[-D + i] = 0;
  }
  if (MODE == 0) {
    const float4 gq0 = *(const float4*)(gain + lane * 4), gq1 = *(const float4*)(gain + 256 + lane * 4);
    const float4 gq2 = *(const float4*)(gain + 512 + lane * 4), gq3 = *(const float4*)(gain + 768 + lane * 4);
    for (int row = bid * 4 + wave; row < R; row += nb * 8) {
      const int row2 = row + nb * 4;
      const bool has2 = row2 < R;
      const int r2 = has2 ? row2 : row;
      float4 va[4], vb[4];
#pragma unroll
      for (int i = 0; i < 4; i++) {
        va[i] = *(const float4*)(H + (size_t)row * D + i * 256 + lane * 4);
        vb[i] = *(const float4*)(H + (size_t)r2 * D + i * 256 + lane * 4);
      }
      float sa = 0.f, sb = 0.f;
#pragma unroll
      for (int i = 0; i < 4; i++) {
        sa += va[i].x * va[i].x + va[i].y * va[i].y + va[i].z * va[i].z + va[i].w * va[i].w;
        sb += vb[i].x * vb[i].x + vb[i].y * vb[i].y + vb[i].z * vb[i].z + vb[i].w * vb[i].w;
      }
      const float ca = rsqrtf(wave_sum_fast(sa) * (1.f / D) + EPS), cb = rsqrtf(wave_sum_fast(sb) * (1.f / D) + EPS);
      const float4 gq[4] = {gq0, gq1, gq2, gq3};
#pragma unroll
      for (int i = 0; i < 4; i++) {
        uint2 o;
        o.x = pack2(va[i].x * ca * gq[i].x, va[i].y * ca * gq[i].y);
        o.y = pack2(va[i].z * ca * gq[i].z, va[i].w * ca * gq[i].w);
        *(uint2*)(hn + (size_t)row * D + i * 256 + lane * 4) = o;
        if (has2) {
          o.x = pack2(vb[i].x * cb * gq[i].x, vb[i].y * cb * gq[i].y);
          o.y = pack2(vb[i].z * cb * gq[i].z, vb[i].w * cb * gq[i].w);
          *(uint2*)(hn + (size_t)row2 * D + i * 256 + lane * 4) = o;
        }
      }
    }
    return;
  }
  for (int row = bid * 4 + wave; row < R; row += nb * 4) {
    const int b = row / LP, pr = row - b * LP;
    float4 v[4];
    if (MODE == 1) {
      const float* src = nullptr;
      if (pr >= 128) src = p.x + ((size_t)b * SEQ + (pr - 128)) * D;
      else if (pr >= PADR) src = p.meta + (size_t)(pr - PADR) * D;
#pragma unroll
      for (int i = 0; i < 4; i++) {
        v[i] = src ? *(const float4*)(src + i * 256 + lane * 4) : make_float4(0.f, 0.f, 0.f, 0.f);
        *(float4*)(H + (size_t)row * D + i * 256 + lane * 4) = v[i];
      }
    } else {
#pragma unroll
      for (int i = 0; i < 4; i++) v[i] = *(const float4*)(H + (size_t)row * D + i * 256 + lane * 4);
    }
    float ss = 0.f;
#pragma unroll
    for (int i = 0; i < 4; i++) ss += v[i].x * v[i].x + v[i].y * v[i].y + v[i].z * v[i].z + v[i].w * v[i].w;
    ss = wave_sum(ss);
    const float sc = rsqrtf(ss * (1.f / D) + EPS);
#pragma unroll
    for (int i = 0; i < 4; i++) {
      const float4 g = *(const float4*)(gain + i * 256 + lane * 4);
      uint2 o;
      o.x = pack2(v[i].x * sc * g.x, v[i].y * sc * g.y);
      o.y = pack2(v[i].z * sc * g.z, v[i].w * sc * g.w);
      *(uint2*)(hn + (size_t)row * D + i * 256 + lane * 4) = o;
    }
  }
}

__device__ __forceinline__ void final_phase(const Params& p, int bid, int nb) {
  const float* H = (const float*)(p.ws + OFF_H);
  const int tid_ = otid(); const int lane = tid_ & 63, wave = tid_ >> 6;
  float4 g[4];
#pragma unroll
  for (int i = 0; i < 4; i++) g[i] = *(const float4*)(p.final_norm + i * 256 + lane * 4);
  for (int t = bid * 4 + wave; t < NB * SEQ; t += nb * 8) {
    const int t2r = t + nb * 4;
    const bool has2 = t2r < NB * SEQ;
    const int t2 = has2 ? t2r : t;
    const size_t ra = (size_t)(t / SEQ) * LP + 128 + (t % SEQ), rb = (size_t)(t2 / SEQ) * LP + 128 + (t2 % SEQ);
    float4 va[4], vb[4];
#pragma unroll
    for (int i = 0; i < 4; i++) {
      va[i] = *(const float4*)(H + ra * D + i * 256 + lane * 4);
      vb[i] = *(const float4*)(H + rb * D + i * 256 + lane * 4);
    }
    float sa = 0.f, sb = 0.f;
#pragma unroll
    for (int i = 0; i < 4; i++) {
      sa += va[i].x * va[i].x + va[i].y * va[i].y + va[i].z * va[i].z + va[i].w * va[i].w;
      sb += vb[i].x * vb[i].x + vb[i].y * vb[i].y + vb[i].z * vb[i].z + vb[i].w * vb[i].w;
    }
    const float ca = rsqrtf(wave_sum_fast(sa) * (1.f / D) + EPS), cb = rsqrtf(wave_sum_fast(sb) * (1.f / D) + EPS);
#pragma unroll
    for (int i = 0; i < 4; i++) {
      *(float4*)(p.out + (size_t)t * D + i * 256 + lane * 4) =
          make_float4(va[i].x * ca * g[i].x, va[i].y * ca * g[i].y, va[i].z * ca * g[i].z, va[i].w * ca * g[i].w);
      if (has2)
        *(float4*)(p.out + (size_t)t2 * D + i * 256 + lane * 4) =
            make_float4(vb[i].x * cb * g[i].x, vb[i].y * cb * g[i].y, vb[i].z * cb * g[i].z, vb[i].w * cb * g[i].w);
    }
  }
}

__device__ __forceinline__ float xrow16_sum(float x) {
  auto s = __builtin_amdgcn_permlane16_swap(__float_as_uint(x), __float_as_uint(x), false, false);
  x = __uint_as_float(s[0]) + __uint_as_float(s[1]);
  auto t = __builtin_amdgcn_permlane32_swap(__float_as_uint(x), __float_as_uint(x), false, false);
  return __uint_as_float(t[0]) + __uint_as_float(t[1]);
}

enum { EPI_SWIGLU = 0, EPI_RESID = 1, EPI_HYB = 2, EPI_RK1 = 3, EPI_LW = 4, EPI_LA = 5, EPI_LG = 6 };
struct Epi {
  float* f0; bf16_t* b0; bf16_t* b1; const float* v0; const bf16_t* c0; float alpha;
  const bf16_t* y01; const bf16_t* y23; const float* mu; const float* sbp; const float* lnw; const float* lnb;
};

template <int EPI, bool SHIFT, int BM = 128>
__device__ __forceinline__ void gemm_phase(const bf16_t* __restrict__ A, int lda, const bf16_t* __restrict__ Wt, int K, int ntn,
                           const Epi e, bf16_t* smem, int bid, int nb, int tbeg = 0, int tend = 1 << 30) {
  const int tid = otid(), lane = tid & 63, wave = tid >> 6;
  const int wm = wave >> 1, wn = wave & 1;
  const int KT = K >> 6;
  const int lrow = tid >> 3, lchunk = tid & 7;
  const int lsw = ((lchunk ^ ((lrow >> 1) & 7)) << 3);
  const int fr = lane & 15, fq = lane >> 4;
  const int fsw = (fr >> 1) & 7;
  constexpr bool TR = true;
  constexpr int MI = BM / 32;
  constexpr int MTX = R / BM;
  constexpr int MREM = MTX % 8;
  const int band = 8 * ntn, nfull = (MTX / 8) * band;
  for (int it = 0;; it++) {
    int tile;
    if (nb == 512) tile = ((it * 8 + (bid & 7)) << 6) + (bid >> 3); else tile = it * nb + bid;
    tile += tbeg;
    if (tile >= MTX * ntn || tile >= tend) break;
    int mt, nt;
    if (tile < nfull) { const int b_ = tile / band, w_ = tile - b_ * band; nt = w_ >> 3; mt = b_ * 8 + (w_ & 7); }
    else { const int w_ = tile - nfull; nt = w_ / MREM; mt = (MTX / 8) * 8 + (w_ - nt * MREM); }
    const int m0 = mt * BM, n0 = nt * 128;
    f32x4 acc[MI][4];
#pragma unroll
    for (int i = 0; i < MI; i++)
#pragma unroll
      for (int j = 0; j < 4; j++) acc[i][j] = (f32x4){0.f, 0.f, 0.f, 0.f};
    if constexpr (BM == 128) {
    const bf16_t* ap = A + (size_t)(m0 + lrow) * lda + lsw;
    const bf16_t* bp = Wt + (size_t)(n0 + lrow) * K + lsw;
    const size_t a32 = (size_t)32 * lda, b32 = (size_t)32 * K;
    typedef __attribute__((address_space(3))) unsigned lds_u32;
    lds_u32* sbase = (lds_u32*)(smem) + wave * 256;
#define GLDS(AP, KC, KW, OFF)                                                                                   \
  __builtin_amdgcn_global_load_lds((const unsigned*)((AP) + (KC)), sbase + (OFF) / 2, 16, 0, 0);               \
  __builtin_amdgcn_global_load_lds((const unsigned*)((AP) + a32 + (KC)), sbase + ((OFF) + 2048) / 2, 16, 0, 0);   \
  __builtin_amdgcn_global_load_lds((const unsigned*)((AP) + 2 * a32 + (KC)), sbase + ((OFF) + 4096) / 2, 16, 0, 0); \
  __builtin_amdgcn_global_load_lds((const unsigned*)((AP) + 3 * a32 + (KC)), sbase + ((OFF) + 6144) / 2, 16, 0, 0); \
  __builtin_amdgcn_global_load_lds((const unsigned*)(bp + (KW)), sbase + ((OFF) + 8192) / 2, 16, 0, 0);           \
  __builtin_amdgcn_global_load_lds((const unsigned*)(bp + b32 + (KW)), sbase + ((OFF) + 8192 + 2048) / 2, 16, 0, 0); \
  __builtin_amdgcn_global_load_lds((const unsigned*)(bp + 2 * b32 + (KW)), sbase + ((OFF) + 8192 + 4096) / 2, 16, 0, 0); \
  __builtin_amdgcn_global_load_lds((const unsigned*)(bp + 3 * b32 + (KW)), sbase + ((OFF) + 8192 + 6144) / 2, 16, 0, 0);
    GLDS(ap, 0, 0, 0)
    asm volatile("s_waitcnt vmcnt(0)" ::: "memory");
    __syncthreads();
    for (int kt = 0; kt < KT; kt++) {
      const int cur = (kt & 1) * 16384;
      if (kt + 1 < KT) {
        const bf16_t* apx = ap;
        int kc = (kt + 1) * 64;
        if (SHIFT && kc >= 1024) { apx = ap - lda; kc -= 1024; }
        const int nxt = ((kt + 1) & 1) * 16384;
        GLDS(apx, kc, (kt + 1) * 64, nxt)
      }
#pragma unroll
      for (int kk = 0; kk < 2; kk++) {
        bf16x8 af[4], bfr[4];
        const int csw = (((kk * 4 + fq) ^ fsw) << 3);
#pragma unroll
        for (int mi = 0; mi < 4; mi++) af[mi] = *(const bf16x8*)(smem + cur + (wm * 64 + mi * 16 + fr) * 64 + csw);
#pragma unroll
        for (int ni = 0; ni < 4; ni++) bfr[ni] = *(const bf16x8*)(smem + cur + 8192 + (wn * 64 + ni * 16 + fr) * 64 + csw);
#pragma unroll
        for (int mi = 0; mi < 4; mi++)
#pragma unroll
          for (int ni = 0; ni < 4; ni++)
            acc[mi][ni] = TR ? __builtin_amdgcn_mfma_f32_16x16x32_bf16(bfr[ni], af[mi], acc[mi][ni], 0, 0, 0)
                             : __builtin_amdgcn_mfma_f32_16x16x32_bf16(af[mi], bfr[ni], acc[mi][ni], 0, 0, 0);
      }
      asm volatile("s_waitcnt vmcnt(0)" ::: "memory");
      __syncthreads();
    }
#undef GLDS
    } else {
      const bf16_t* ap = A + (size_t)(m0 + lrow) * lda + lsw;
      const bf16_t* bp = Wt + (size_t)(n0 + lrow) * K + lsw;
      const size_t a32 = (size_t)32 * lda, b32 = (size_t)32 * K;
      typedef __attribute__((address_space(3))) unsigned lds_u32;
      lds_u32* sbase = (lds_u32*)(smem) + wave * 256;
      for (int kt = 0; kt < KT; kt++) {
        {
          const bf16_t* apx = ap;
          int kc = kt * 64;
          if (SHIFT && kc >= 1024) { apx = ap - lda; kc -= 1024; }
#pragma unroll
          for (int i = 0; i < 8; i++)
            __builtin_amdgcn_global_load_lds((const unsigned*)(apx + i * a32 + kc), sbase + i * 1024, 16, 0, 0);
#pragma unroll
          for (int i = 0; i < 4; i++)
            __builtin_amdgcn_global_load_lds((const unsigned*)(bp + i * b32 + kt * 64), sbase + 8192 + i * 1024, 16, 0, 0);
        }
        asm volatile("s_waitcnt vmcnt(0)" ::: "memory");
        __syncthreads();
#pragma unroll
        for (int kk = 0; kk < 2; kk++) {
          bf16x8 af[MI], bfr[4];
          const int csw = (((kk * 4 + fq) ^ fsw) << 3);
#pragma unroll
          for (int mi = 0; mi < MI; mi++) af[mi] = *(const bf16x8*)(smem + (wm * 128 + mi * 16 + fr) * 64 + csw);
#pragma unroll
          for (int ni = 0; ni < 4; ni++) bfr[ni] = *(const bf16x8*)(smem + 16384 + (wn * 64 + ni * 16 + fr) * 64 + csw);
#pragma unroll
          for (int mi = 0; mi < MI; mi++)
#pragma unroll
            for (int ni = 0; ni < 4; ni++)
              acc[mi][ni] = __builtin_amdgcn_mfma_f32_16x16x32_bf16(bfr[ni], af[mi], acc[mi][ni], 0, 0, 0);
        }
        __syncthreads();
      }
    }
    if constexpr (!TR) {
    const unsigned rbase = (unsigned)(m0 + wm * 64 + fq * 4);
    const unsigned cbase = (unsigned)(n0 + wn * 64 + fr);
#pragma unroll
    for (int mi = 0; mi < 4; mi++) {
#pragma unroll
      for (int j = 0; j < 4; j++) {
        const unsigned row = rbase + mi * 16 + j;
        if constexpr (EPI == EPI_SWIGLU) {
#pragma unroll
          for (int np = 0; np < 2; np++) {
            const unsigned hc = ((unsigned)(n0 + wn * 64) >> 1) + np * 16 + fr;
            const float g = acc[mi][2 * np][j], u = acc[mi][2 * np + 1][j];
            e.b0[row * (unsigned)DFF + hc] = f2bf(siluf_(g) * u);
          }
        } else {
          const unsigned pr = row % (unsigned)LP;
#pragma unroll
          for (int ni = 0; ni < 4; ni++) {
            const unsigned col = cbase + ni * 16;
            const float a = acc[mi][ni][j];
            if constexpr (EPI == EPI_RESID) {
              if (pr >= PADR) { float* hp = e.f0 + (row * (unsigned)D + col); *hp = *hp + e.alpha * a; }
            } else if constexpr (EPI == EPI_HYB) {
              if (col >= 1024 && col < 1536) {
                const unsigned bb = row / (unsigned)LP;
                e.b1[((bb * 8u + ((col - 1024) >> 6)) * 64u + (col & 63)) * (unsigned)LP + (row - bb * (unsigned)LP)] = f2bf(a);
              } else if (col < ZLD) e.b0[row * (unsigned)ZLD + col] = f2bf(a);
              else if (col < ZLD + 16) e.f0[row * 16u + (col - ZLD)] = a;
            } else if constexpr (EPI == EPI_RK1) {
              if (col < 3072) e.b0[row * (unsigned)RKLD + col] = f2bf(a);
              else if (col < 3136) e.b1[row * (unsigned)MIDLD + (col - 3072)] = f2bf(tanhf(a));
              else if (col < 3200) e.b1[row * (unsigned)MIDLD + (col - 3072)] = f2bf(a);
              else if (col < 3360) e.b1[row * (unsigned)MIDLD + (col - 3072)] = f2bf(sigmoidf_(a));
              else if (col < 3392) e.b1[row * (unsigned)MIDLD + (col - 3072)] = 0;
            } else if constexpr (EPI == EPI_LW) {
              const float wl = -softplusf_(-(e.v0[col] + a)) - 0.5f;
              e.b0[row * (unsigned)D + col] = f2bf(__expf(wl));
            } else if constexpr (EPI == EPI_LA) {
              e.b0[row * (unsigned)D + col] = f2bf(sigmoidf_(e.v0[col] + a));
            } else if constexpr (EPI == EPI_LG) {
              const float yv = bf2f(e.c0[row * (unsigned)RKLD + 2048 + col]);
              e.b0[row * (unsigned)D + col] = (pr >= PADR) ? f2bf(a * yv) : (bf16_t)0;
            }
          }
        }
        __builtin_amdgcn_sched_barrier(0);
      }
    }
    } else {
      const unsigned rb2 = (unsigned)(m0 + wm * (BM / 2) + fr);
      const unsigned cb2 = (unsigned)(n0 + wn * 64 + fq * 4);
#pragma unroll
      for (int mi = 0; mi < MI; mi++) {
        const unsigned row = rb2 + mi * 16;
        const unsigned pr = row % (unsigned)LP;
        if constexpr (EPI == EPI_LG) {
          const unsigned hh = (unsigned)(n0 + wn * 64) >> 6;
          const unsigned bb = row / (unsigned)LP;
          const bf16_t* yb = (bb < 2u) ? (e.y01 + (size_t)bb * LP * D) : (e.y23 + (size_t)(bb - 2u) * LP * D);
          float yv[4][4], vv[4][4];
          float s1 = 0.f;
#pragma unroll
          for (int ni = 0; ni < 4; ni++) {
            const unsigned col = cb2 + ni * 16;
            const uint2 yu = *(const uint2*)(yb + (size_t)pr * D + col);
            const uint2 vu = *(const uint2*)(e.c0 + (row * (unsigned)RKLD + 2048 + col));
            const float m_ = e.mu[row * 64u + hh * 4u + ni];
            yv[ni][0] = bf2f((bf16_t)(yu.x & 0xffff)) + m_; yv[ni][1] = bf2f((bf16_t)(yu.x >> 16)) + m_;
            yv[ni][2] = bf2f((bf16_t)(yu.y & 0xffff)) + m_; yv[ni][3] = bf2f((bf16_t)(yu.y >> 16)) + m_;
            vv[ni][0] = bf2f((bf16_t)(vu.x & 0xffff)); vv[ni][1] = bf2f((bf16_t)(vu.x >> 16));
            vv[ni][2] = bf2f((bf16_t)(vu.y & 0xffff)); vv[ni][3] = bf2f((bf16_t)(vu.y >> 16));
            s1 += (yv[ni][0] + yv[ni][1]) + (yv[ni][2] + yv[ni][3]);
          }
          const float mean = xrow16_sum(s1) * (1.f / 64.f);
          float s2 = 0.f;
#pragma unroll
          for (int ni = 0; ni < 4; ni++)
#pragma unroll
            for (int j = 0; j < 4; j++) { yv[ni][j] -= mean; s2 += yv[ni][j] * yv[ni][j]; }
          const float rstd = rsqrtf(xrow16_sum(s2) * (1.f / 64.f) + 64e-5f);
          const float sb = e.sbp[row * 16u + hh];
#pragma unroll
          for (int ni = 0; ni < 4; ni++) {
            const unsigned col = cb2 + ni * 16;
            const float4 lw = *(const float4*)(e.lnw + col), lb = *(const float4*)(e.lnb + col);
            const f32x4 a = acc[mi][ni];
            uint2 o;
            o.x = pack2(a[0] * (yv[ni][0] * rstd * lw.x + lb.x + sb * vv[ni][0]), a[1] * (yv[ni][1] * rstd * lw.y + lb.y + sb * vv[ni][1]));
            o.y = pack2(a[2] * (yv[ni][2] * rstd * lw.z + lb.z + sb * vv[ni][2]), a[3] * (yv[ni][3] * rstd * lw.w + lb.w + sb * vv[ni][3]));
            if (pr < PADR) { o.x = 0u; o.y = 0u; }
            *(uint2*)(e.b0 + (row * (unsigned)D + col)) = o;
          }
        } else if constexpr (EPI == EPI_SWIGLU) {
#pragma unroll
          for (int np = 0; np < 2; np++) {
            const unsigned hc = ((unsigned)(n0 + wn * 64) >> 1) + np * 16 + fq * 4;
            const f32x4 g = acc[mi][2 * np], u = acc[mi][2 * np + 1];
            uint2 o;
            o.x = pack2(siluf_(g[0]) * u[0], siluf_(g[1]) * u[1]);
            o.y = pack2(siluf_(g[2]) * u[2], siluf_(g[3]) * u[3]);
            *(uint2*)(e.b0 + (row * (unsigned)DFF + hc)) = o;
          }
        } else {
#pragma unroll
          for (int ni = 0; ni < 4; ni++) {
            const unsigned col = cb2 + ni * 16;
            const f32x4 a = acc[mi][ni];
            if constexpr (EPI == EPI_RESID) {
              if (pr >= PADR) {
                float4* hp = (float4*)(e.f0 + (row * (unsigned)D + col));
                float4 hv = *hp;
                hv.x += e.alpha * a[0]; hv.y += e.alpha * a[1]; hv.z += e.alpha * a[2]; hv.w += e.alpha * a[3];
                *hp = hv;
              }
            } else if constexpr (EPI == EPI_HYB) {
              if (col >= 1024 && col < 1536) {
                const unsigned bb = row / (unsigned)LP;
                const unsigned vb_ = ((bb * 8u + ((col - 1024) >> 6)) * 64u + (col & 63)) * (unsigned)LP + (row - bb * (unsigned)LP);
                e.b1[vb_] = f2bf(a[0]); e.b1[vb_ + LP] = f2bf(a[1]); e.b1[vb_ + 2 * LP] = f2bf(a[2]); e.b1[vb_ + 3 * LP] = f2bf(a[3]);
              } else if (col < ZLD) {
                uint2 o; o.x = pack2(a[0], a[1]); o.y = pack2(a[2], a[3]);
                *(uint2*)(e.b0 + (row * (unsigned)ZLD + col)) = o;
              } else if (col < ZLD + 16) {
                *(float4*)(e.f0 + (row * 16u + (col - ZLD))) = make_float4(a[0], a[1], a[2], a[3]);
              }
            } else if constexpr (EPI == EPI_RK1) {
              uint2 o;
              if (col < 3072) {
                o.x = pack2(a[0], a[1]); o.y = pack2(a[2], a[3]);
                *(uint2*)(e.b0 + (row * (unsigned)RKLD + col)) = o;
              } else if (col < 3392) {
                if (col < 3136) { o.x = pack2(tanhf(a[0]), tanhf(a[1])); o.y = pack2(tanhf(a[2]), tanhf(a[3])); }
                else if (col < 3200) { o.x = pack2(a[0], a[1]); o.y = pack2(a[2], a[3]); }
                else if (col < 3360) { o.x = pack2(sigmoidf_(a[0]), sigmoidf_(a[1])); o.y = pack2(sigmoidf_(a[2]), sigmoidf_(a[3])); }
                else { o.x = 0u; o.y = 0u; }
                *(uint2*)(e.b1 + (row * (unsigned)MIDLD + (col - 3072))) = o;
              }
            } else if constexpr (EPI == EPI_LW) {
              const float4 w0v = *(const float4*)(e.v0 + col);
              uint2 o;
              o.x = pack2(__expf(-softplusf_(-(w0v.x + a[0])) - 0.5f), __expf(-softplusf_(-(w0v.y + a[1])) - 0.5f));
              o.y = pack2(__expf(-softplusf_(-(w0v.z + a[2])) - 0.5f), __expf(-softplusf_(-(w0v.w + a[3])) - 0.5f));
              *(uint2*)(e.b0 + (row * (unsigned)D + col)) = o;
            } else if constexpr (EPI == EPI_LA) {
              const float4 a0v = *(const float4*)(e.v0 + col);
              uint2 o;
              o.x = pack2(sigmoidf_(a0v.x + a[0]), sigmoidf_(a0v.y + a[1]));
              o.y = pack2(sigmoidf_(a0v.z + a[2]), sigmoidf_(a0v.w + a[3]));
              *(uint2*)(e.b0 + (row * (unsigned)D + col)) = o;
            } else if constexpr (EPI == EPI_LG) {
              const uint2 yv = *(const uint2*)(e.c0 + (row * (unsigned)RKLD + 2048 + col));
              uint2 o;
              o.x = pack2(a[0] * bf2f((bf16_t)(yv.x & 0xffff)), a[1] * bf2f((bf16_t)(yv.x >> 16)));
              o.y = pack2(a[2] * bf2f((bf16_t)(yv.y & 0xffff)), a[3] * bf2f((bf16_t)(yv.y >> 16)));
              if (pr < PADR) { o.x = 0u; o.y = 0u; }
              *(uint2*)(e.b0 + (row * (unsigned)D + col)) = o;
            }
          }
        }
        __builtin_amdgcn_sched_barrier(0);
      }
    }
  }
}

__device__ __forceinline__ void hyb_prep_phase(const Params& p, float* sm, int bid, int nb) {
  const bf16_t* z = (const bf16_t*)(p.ws + OFF_BIG);
  const float* zg = (const float*)(p.ws + OFF_ZG);
  float* cf = (float*)(p.ws + OFF_CF);
  float* gg = (float*)(p.ws + OFF_GG);
  bf16_t* gp = (bf16_t*)p.out;
  const int tid = otid(); const int lane = tid & 63, wave = tid >> 6;
  for (int item = bid; item < NB * 8; item += nb) {
    const int b = item >> 3, h = item & 7;
    const float bf = p.hyb_fox_bf[h];
    const int p0 = tid * 33;
    float x[33];
    float s = 0.f;
#pragma unroll
    for (int i = 0; i < 33; i++) {
      const int pr = p0 + i;
      float lf = 0.f;
      if (pr >= PADR && pr < LP) lf = logsigf_(zg[((size_t)b * LP + pr) * 16 + h] + bf);
      x[i] = lf; s += lf;
    }
    float inc = s;
#pragma unroll
    for (int o = 1; o < 64; o <<= 1) {
      const float t = __shfl_up(inc, o);
      if (lane >= o) inc += t;
    }
    __syncthreads();
    if (lane == 63) sm[wave] = inc;
    __syncthreads();
    float run = inc - s;
    if (wave > 0) run += sm[0];
    if (wave > 1) run += sm[1];
    if (wave > 2) run += sm[2];
#pragma unroll
    for (int i = 0; i < 33; i++) {
      const int pr = p0 + i;
      run += x[i];
      if (pr < LP) cf[((size_t)b * 8 + h) * LP + pr] = run;
    }
  }
  {
    unsigned* stats = (unsigned*)(p.ws + OFF_STAT);
    for (int it = bid * 4 + wave; it < NB * 8 * 65; it += nb * 4) {
      const int bh = it / 65, seg = it - bh * 65;
      const int b = bh >> 3, h = bh & 7;
      float mq = 0.f, mk = 0.f;
#pragma unroll 4
      for (int g8 = 0; g8 < 16; g8++) {
        const size_t row = (size_t)b * LP + seg * 128 + g8 * 8 + (lane >> 3);
        const uint4 uq = *(const uint4*)(z + row * ZLD + h * 64 + (lane & 7) * 8);
        const uint4 uk = *(const uint4*)(z + row * ZLD + 512 + h * 64 + (lane & 7) * 8);
        const unsigned aq[4] = {uq.x, uq.y, uq.z, uq.w}, ak[4] = {uk.x, uk.y, uk.z, uk.w};
        float sq = 0.f, sk = 0.f;
#pragma unroll
        for (int e = 0; e < 4; e++) {
          const float q0 = bf2f((bf16_t)(aq[e] & 0xffff)), q1 = bf2f((bf16_t)(aq[e] >> 16));
          const float k0 = bf2f((bf16_t)(ak[e] & 0xffff)), k1 = bf2f((bf16_t)(ak[e] >> 16));
          sq += q0 * q0 + q1 * q1; sk += k0 * k0 + k1 * k1;
        }
        mq = fmaxf(mq, dpp_sum8(sq)); mk = fmaxf(mk, dpp_sum8(sk));
      }
#pragma unroll
      for (int o = 32; o > 0; o >>= 1) { mq = fmaxf(mq, __shfl_xor(mq, o)); mk = fmaxf(mk, __shfl_xor(mk, o)); }
      if (lane == 0) { atomicMax(&stats[bh * 2], __float_as_uint(mq)); atomicMax(&stats[bh * 2 + 1], __float_as_uint(mk)); }
    }
  }
  for (int row = bid * 4 + wave; row < R; row += nb * 4) {
    const int pr = row % LP;
    if (pr < PADR) continue;
    float y[12][2];
#pragma unroll
    for (int g = 0; g < 12; g++) {
      const int c = g * 128 + lane * 2;
      float y0 = 0.f, y1 = 0.f;
#pragma unroll
      for (int j = 0; j < 4; j++) {
        const unsigned u = *(const unsigned*)(z + (size_t)(row - 3 + j) * ZLD + 1536 + c);
        const float2 w = *(const float2*)(p.hyb_conv + j * 1536 + c);
        y0 += w.x * bf2f((bf16_t)(u & 0xffff));
        y1 += w.y * bf2f((bf16_t)(u >> 16));
      }
      y[g][0] = siluf_(y0); y[g][1] = siluf_(y1);
    }
#pragma unroll
    for (int g = 0; g < 8; g++) {
      const float n2 = wave_sum_fast(y[g][0] * y[g][0] + y[g][1] * y[g][1]);
      const float sc = rsqrtf(n2 + EPS);
      y[g][0] *= sc; y[g][1] *= sc;
    }
#pragma unroll
    for (int g = 0; g < 12; g++) *(unsigned*)(gp + (size_t)row * 1536 + g * 128 + lane * 2) = pack2(y[g][0], y[g][1]);
    if (lane < 4) {
      const float ga = zg[(size_t)row * 16 + 8 + lane], gb = zg[(size_t)row * 16 + 12 + lane];
      gg[(size_t)row * 8 + lane] = -__expf(p.hyb_a_log[lane]) * softplus_acc(ga + p.hyb_dt_bias[lane]);
      gg[(size_t)row * 8 + 4 + lane] = sigmoidf_(gb);
    }
  }
}

__device__ __forceinline__ void fox_item(const Params& p, int item, float* smf) {
  const int QT = 33;
  const int bh = item / QT, qt = item - bh * QT;
  const int b = bh >> 3, h = bh & 7;
  bf16_t* sm = (bf16_t*)smf;
  float* sC = smf + 8192;
  const bf16_t* z = (const bf16_t*)(p.ws + OFF_BIG);
  const bf16_t* vt = (const bf16_t*)(p.ws + OFF_VT) + (size_t)bh * 64 * LP;
  const float* cf = (const float*)(p.ws + OFF_CF) + (size_t)bh * LP;
  bf16_t* O = (bf16_t*)(p.ws + OFF_O);
  const int tid = otid(), lane = tid & 63, wave = tid >> 6;
  const int fr = lane & 15, g = lane >> 4;
  const int fsw = (fr >> 1) & 7;
  const int q0 = qt * 256, qw0 = q0 + wave * 64;
  const int kdiag = qw0 >> 6;
  const size_t rowb = (size_t)b * LP;
  constexpr float SC2 = 0.18033688011112042f;
  constexpr float LOG2E = 1.4426950408889634f;
  bf16x8 qf[4][2];
#pragma unroll
  for (int qb = 0; qb < 4; qb++) {
    int r = qw0 + qb * 16 + fr; if (r > LP - 1) r = LP - 1;
#pragma unroll
    for (int ks = 0; ks < 2; ks++) qf[qb][ks] = *(const bf16x8*)(z + (rowb + r) * ZLD + h * 64 + ks * 32 + g * 8);
  }
  f32x4 o[4][4];
#pragma unroll
  for (int i = 0; i < 4; i++)
#pragma unroll
    for (int k = 0; k < 4; k++) o[i][k] = (f32x4){0.f, 0.f, 0.f, 0.f};
  float m[4], l[4];
#pragma unroll
  for (int i = 0; i < 4; i++) { m[i] = -1e30f; l[i] = 0.f; }
  int kt_hi = (q0 + 255) >> 6; if (kt_hi > LP / 64 - 1) kt_hi = LP / 64 - 1;
  int kt_lo = 1;
  {
    const unsigned* stats = (const unsigned*)(p.ws + OFF_STAT);
    const float margin = 2.f * 0.125f * sqrtf(__uint_as_float(stats[bh * 2]) * __uint_as_float(stats[bh * 2 + 1]));
    const float cq0 = cf[q0 < PADR ? PADR : q0];
    int found = -1;
#pragma unroll
    for (int base = 0; base < 192; base += 64) {
      const int ktc = base + lane;
      int ke = ktc * 64 + 63; if (ke > LP - 1) ke = LP - 1;
      const bool ok = (ktc >= 1) && (ktc <= kt_hi) && (margin + cq0 - cf[ke] >= -90.f);
      const unsigned long long bal = __ballot(ok);
      if (found < 0 && bal != 0ull) found = base + __ffsll((long long)bal) - 1;
    }
    if (found > 1) kt_lo = found;
  }
  const int lrow = tid >> 3, lchunk = tid & 7;
  const int lsw = ((lchunk ^ ((lrow >> 1) & 7)) << 3);
  uint4 rk0, rk1, rv0, rv1; float rc = 0.f;
#define FOX_LOAD(KT)                                                                         \
  {                                                                                          \
    const bf16_t* kp = z + (rowb + (KT) * 64 + lrow) * ZLD + 512 + h * 64 + lchunk * 8;      \
    rk0 = *(const uint4*)kp; rk1 = *(const uint4*)(kp + (size_t)32 * ZLD);                    \
    const bf16_t* vp = vt + (size_t)lrow * LP + (KT) * 64 + lchunk * 8;                       \
    rv0 = *(const uint4*)vp; rv1 = *(const uint4*)(vp + (size_t)32 * LP);                     \
    if (tid < 64) rc = -cf[(KT) * 64 + tid] * LOG2E;                                          \
  }
#define FOX_STORE(BI)                                                                        \
  {                                                                                          \
    bf16_t* d = sm + (BI) * 8192 + lrow * 64 + lsw;                                          \
    *(uint4*)d = rk0; *(uint4*)(d + 2048) = rk1; *(uint4*)(d + 4096) = rv0; *(uint4*)(d + 4096 + 2048) = rv1; \
    if (tid < 64) sC[(BI) * 64 + tid] = rc;                                                   \
  }
  __syncthreads();
  FOX_LOAD(kt_hi)
  FOX_STORE(0)
  __syncthreads();
  int bi = 0;
  for (int kt = kt_hi; kt >= kt_lo; kt--) {
    if (kt > kt_lo) FOX_LOAD(kt - 1)
    if (kt <= kdiag) {
      const bf16_t* sK = sm + bi * 8192;
      const bf16_t* sV = sK + 4096;
      const float* sCc = sC + bi * 64;
      const bool special = (kt == kdiag) || (kt == 1);
#pragma unroll 1
      for (int ks2 = 0; ks2 < 2; ks2++) {
        f32x4 s[2][4];
#pragma unroll
        for (int kbl = 0; kbl < 2; kbl++)
#pragma unroll
          for (int qb = 0; qb < 4; qb++) s[kbl][qb] = (f32x4){0.f, 0.f, 0.f, 0.f};
#pragma unroll
        for (int kbl = 0; kbl < 2; kbl++) {
#pragma unroll
          for (int ds = 0; ds < 2; ds++) {
            const bf16x8 kf = *(const bf16x8*)(sK + (16 * (2 * ks2 + kbl) + fr) * 64 + (((ds * 4 + g) ^ fsw) << 3));
#pragma unroll
            for (int qb = 0; qb < 4; qb++) s[kbl][qb] = __builtin_amdgcn_mfma_f32_16x16x32_bf16(kf, qf[qb][ds], s[kbl][qb], 0, 0, 0);
          }
        }
        float4 ck[2];
        ck[0] = *(const float4*)(sCc + 16 * (2 * ks2) + 4 * g);
        ck[1] = *(const float4*)(sCc + 16 * (2 * ks2 + 1) + 4 * g);
        float mt[4];
#pragma unroll
        for (int qb = 0; qb < 4; qb++) mt[qb] = -1e30f;
#pragma unroll
        for (int kbl = 0; kbl < 2; kbl++) {
#pragma unroll
          for (int qb = 0; qb < 4; qb++) {
            s[kbl][qb][0] = s[kbl][qb][0] * SC2 + ck[kbl].x;
            s[kbl][qb][1] = s[kbl][qb][1] * SC2 + ck[kbl].y;
            s[kbl][qb][2] = s[kbl][qb][2] * SC2 + ck[kbl].z;
            s[kbl][qb][3] = s[kbl][qb][3] * SC2 + ck[kbl].w;
          }
        }
        if (special) {
#pragma unroll
          for (int kbl = 0; kbl < 2; kbl++)
#pragma unroll
            for (int qb = 0; qb < 4; qb++)
#pragma unroll
              for (int j = 0; j < 4; j++) {
                const int kl = 32 * ks2 + 16 * kbl + 4 * g + j;
                const int ql = 16 * qb + fr;
                bool ok = true;
                if (kt == kdiag) ok = ok && (kl <= ql);
                if (kt == 1) ok = ok && (kl >= 48);
                if (!ok) s[kbl][qb][j] = -1e30f;
              }
        }
#pragma unroll
        for (int kbl = 0; kbl < 2; kbl++)
#pragma unroll
          for (int qb = 0; qb < 4; qb++)
            mt[qb] = fmaxf(mt[qb], fmaxf(fmaxf(s[kbl][qb][0], s[kbl][qb][1]), fmaxf(s[kbl][qb][2], s[kbl][qb][3])));
        bool need = false;
#pragma unroll
        for (int qb = 0; qb < 4; qb++) {
          mt[qb] = fmaxf(mt[qb], __shfl_xor(mt[qb], 16));
          mt[qb] = fmaxf(mt[qb], __shfl_xor(mt[qb], 32));
          need = need || (mt[qb] > m[qb]);
        }
        if (__any(need)) {
#pragma unroll
          for (int qb = 0; qb < 4; qb++) {
            const float mn = fmaxf(m[qb], mt[qb]);
            const float al = __builtin_amdgcn_exp2f(m[qb] - mn);
            m[qb] = mn;
            l[qb] *= al;
#pragma unroll
            for (int db = 0; db < 4; db++) { o[db][qb][0] *= al; o[db][qb][1] *= al; o[db][qb][2] *= al; o[db][qb][3] *= al; }
          }
        }
        bf16x8 pf[4];
#pragma unroll
        for (int qb = 0; qb < 4; qb++) {
          float pv[8];
#pragma unroll
          for (int kbl = 0; kbl < 2; kbl++)
#pragma unroll
            for (int j = 0; j < 4; j++) {
              const float e = __builtin_amdgcn_exp2f(s[kbl][qb][j] - m[qb]);
              pv[kbl * 4 + j] = e;
              l[qb] += e;
            }
          union { bf16x8 v; unsigned u[4]; } cv;
          cv.u[0] = pack2(pv[0], pv[1]); cv.u[1] = pack2(pv[2], pv[3]); cv.u[2] = pack2(pv[4], pv[5]); cv.u[3] = pack2(pv[6], pv[7]);
          pf[qb] = cv.v;
        }
#pragma unroll
        for (int db = 0; db < 4; db++) {
          const int c0 = 4 * ks2 + (g >> 1);
          const bf16_t* vr = sV + (16 * db + fr) * 64 + (g & 1) * 4;
          union { bf16x8 v; uint2 u[2]; } vf;
          vf.u[0] = *(const uint2*)(vr + ((c0 ^ fsw) << 3));
          vf.u[1] = *(const uint2*)(vr + (((c0 + 2) ^ fsw) << 3));
#pragma unroll
          for (int qb = 0; qb < 4; qb++) o[db][qb] = __builtin_amdgcn_mfma_f32_16x16x32_bf16(vf.v, pf[qb], o[db][qb], 0, 0, 0);
        }
      }
    }
    if (kt > kt_lo) FOX_STORE(bi ^ 1)
    __syncthreads();
    bi ^= 1;
  }
#undef FOX_LOAD
#undef FOX_STORE
#pragma unroll
  for (int qb = 0; qb < 4; qb++) {
    float lt = l[qb];
    lt += __shfl_xor(lt, 16);
    lt += __shfl_xor(lt, 32);
    const int r = qw0 + qb * 16 + fr;
    if (r >= PADR && r < LP) {
      const float inv = 1.f / lt;
      bf16_t* op = O + (rowb + r) * D + h * 64 + 4 * g;
#pragma unroll
      for (int db = 0; db < 4; db++) {
        uint2 u;
        u.x = pack2(o[db][qb][0] * inv, o[db][qb][1] * inv);
        u.y = pack2(o[db][qb][2] * inv, o[db][qb][3] * inv);
        *(uint2*)(op + 16 * db) = u;
      }
    }
  }
}


__device__ __forceinline__ void gdn_item(const Params& p, int item, float* sm) {
  const int b = item >> 5, h = (item >> 3) & 3, c0 = (item & 7) * 16;
  const bf16_t* gp = (const bf16_t*)p.out;
  const float* gg = (const float*)(p.ws + OFF_GG);
  bf16_t* O = (bf16_t*)(p.ws + OFF_O);
  constexpr int TC = 16;
  constexpr int BUF = 2 * TC * 128 + TC * 16 + 2 * TC + TC * 16 + TC;
  const int tid = otid(), lane = tid & 63, wave = tid >> 6;
  const int sub = lane & 15, cw = wave * 4 + (lane >> 4);
  const int ltt = tid >> 4, lseg = tid & 15;
  float S[8];
#pragma unroll
  for (int i = 0; i < 8; i++) S[i] = 0.f;
  const size_t rowb = (size_t)b * LP;
  uint4 pq, pk; bf16_t pv; float pg = 0.f, pb = 0.f;
#define GDN_LOAD(T0)                                                                 \
  {                                                                                  \
    const size_t row = rowb + (T0) + ltt;                                            \
    pq = *(const uint4*)(gp + row * 1536 + h * 128 + lseg * 8);                      \
    pk = *(const uint4*)(gp + row * 1536 + 512 + h * 128 + lseg * 8);                \
    pv = gp[row * 1536 + 1024 + h * 128 + c0 + lseg];                                \
    if (tid < TC) { pg = gg[(rowb + (T0) + tid) * 8 + h]; pb = gg[(rowb + (T0) + tid) * 8 + 4 + h]; } \
  }
#define GDN_STORE(BI)                                                                \
  {                                                                                  \
    float* bq = sm + (BI) * BUF + ltt * 128 + lseg * 8;                              \
    float* bk = bq + TC * 128;                                                       \
    *(float4*)(bq) = make_float4(bf2f((bf16_t)(pq.x & 0xffff)), bf2f((bf16_t)(pq.x >> 16)), bf2f((bf16_t)(pq.y & 0xffff)), bf2f((bf16_t)(pq.y >> 16))); \
    *(float4*)(bq + 4) = make_float4(bf2f((bf16_t)(pq.z & 0xffff)), bf2f((bf16_t)(pq.z >> 16)), bf2f((bf16_t)(pq.w & 0xffff)), bf2f((bf16_t)(pq.w >> 16))); \
    *(float4*)(bk) = make_float4(bf2f((bf16_t)(pk.x & 0xffff)), bf2f((bf16_t)(pk.x >> 16)), bf2f((bf16_t)(pk.y & 0xffff)), bf2f((bf16_t)(pk.y >> 16))); \
    *(float4*)(bk + 4) = make_float4(bf2f((bf16_t)(pk.z & 0xffff)), bf2f((bf16_t)(pk.z >> 16)), bf2f((bf16_t)(pk.w & 0xffff)), bf2f((bf16_t)(pk.w >> 16))); \
    sm[(BI) * BUF + 2 * TC * 128 + ltt * 16 + lseg] = bf2f(pv);                       \
    {                                                                                \
      const float4 qa_ = *(const float4*)(bq), qb_ = *(const float4*)(bq + 4);       \
      const float4 ka_ = *(const float4*)(bk), kb_ = *(const float4*)(bk + 4);       \
      const float part_ = (qa_.x * ka_.x + qa_.y * ka_.y + qa_.z * ka_.z + qa_.w * ka_.w) + \
                          (qb_.x * kb_.x + qb_.y * kb_.y + qb_.z * kb_.z + qb_.w * kb_.w);  \
      const float tot_ = dpp_sum16(part_);                                           \
      if (lseg == 0) sm[(BI) * BUF + 2 * TC * 128 + TC * 16 + 2 * TC + TC * 16 + ltt] = tot_; \
    }                                                                                \
    if (tid < TC) { sm[(BI) * BUF + 2 * TC * 128 + TC * 16 + tid] = __expf(pg); sm[(BI) * BUF + 2 * TC * 128 + TC * 16 + TC + tid] = pb; } \
  }
  __syncthreads();
  GDN_LOAD(PADR)
  GDN_STORE(0)
  __syncthreads();
  constexpr int NCH = (LP - PADR) / TC;
  for (int ch = 0; ch < NCH; ch++) {
    const int bi = ch & 1;
    const int t0 = PADR + ch * TC;
    if (ch + 1 < NCH) GDN_LOAD(t0 + TC)
    {
      const float* bq = sm + bi * BUF;
      const float* bk = bq + TC * 128;
      const float* bv = bq + 2 * TC * 128;
      const float* bg = bv + TC * 16;
      float* bo = sm + bi * BUF + 2 * TC * 128 + TC * 16 + 2 * TC;
      float oreg[TC];
#pragma unroll
      for (int t = 0; t < TC; t++) {
        const float4 k0 = *(const float4*)(bk + t * 128 + sub * 4);
        const float4 k1 = *(const float4*)(bk + t * 128 + 64 + sub * 4);
        const float4 q0 = *(const float4*)(bq + t * 128 + sub * 4);
        const float4 q1 = *(const float4*)(bq + t * 128 + 64 + sub * 4);
        const float v = bv[t * 16 + cw];
        const float g = bg[t], be = bg[TC + t];
        const float qk = bo[TC * 16 + t];
        float pa = k0.x * S[0] + k0.y * S[1];
        float pb2 = k0.z * S[2] + k0.w * S[3];
        float qa = q0.x * S[0] + q0.y * S[1];
        float qb2 = q0.z * S[2] + q0.w * S[3];
        pa += k1.x * S[4] + k1.y * S[5];
        pb2 += k1.z * S[6] + k1.w * S[7];
        qa += q1.x * S[4] + q1.y * S[5];
        qb2 += q1.z * S[6] + q1.w * S[7];
        const float ks = dpp_sum16(pa + pb2);
        const float qs = dpp_sum16(qa + qb2);
        const float coef = be * (v - g * ks);
        const float oo = g * qs + coef * qk;
        S[0] = g * S[0] + coef * k0.x; S[1] = g * S[1] + coef * k0.y; S[2] = g * S[2] + coef * k0.z; S[3] = g * S[3] + coef * k0.w;
        S[4] = g * S[4] + coef * k1.x; S[5] = g * S[5] + coef * k1.y; S[6] = g * S[6] + coef * k1.z; S[7] = g * S[7] + coef * k1.w;
        oreg[t] = oo * 0.08838834764831845f;
      }
      if (sub == 0) {
#pragma unroll
        for (int t = 0; t < TC; t++) bo[t * 16 + cw] = oreg[t];
      }
    }
    if (ch + 1 < NCH) GDN_STORE(bi ^ 1)
    __syncthreads();
    {
      const float ov = sm[bi * BUF + 2 * TC * 128 + TC * 16 + 2 * TC + ltt * 16 + lseg];
      O[(rowb + t0 + ltt) * D + 512 + h * 128 + c0 + lseg] = f2bf(ov);
    }
  }
#undef GDN_LOAD
#undef GDN_STORE
  __syncthreads();
}

__device__ __forceinline__ void gdn_norm_phase(const Params& p, int bid, int nb) {
  const bf16_t* z = (const bf16_t*)(p.ws + OFF_BIG);
  bf16_t* O = (bf16_t*)(p.ws + OFF_O);
  const int tid_ = otid(); const int lane = tid_ & 63, wave = tid_ >> 6;
  const float g0 = p.hyb_o_gain[lane * 2], g1 = p.hyb_o_gain[lane * 2 + 1];
  for (int row = bid * 4 + wave; row < R; row += nb * 4) {
    if ((row % LP) < PADR) continue;
    unsigned u[4], gz[4];
#pragma unroll
    for (int h = 0; h < 4; h++) {
      u[h] = *(const unsigned*)(O + (size_t)row * D + 512 + h * 128 + lane * 2);
      gz[h] = *(const unsigned*)(z + (size_t)row * ZLD + 3072 + h * 128 + lane * 2);
    }
#pragma unroll
    for (int h = 0; h < 4; h++) {
      const float o0 = bf2f((bf16_t)(u[h] & 0xffff)), o1 = bf2f((bf16_t)(u[h] >> 16));
      const float ss = wave_sum_fast(o0 * o0 + o1 * o1);
      const float sc = rsqrtf(ss * (1.f / 128.f) + EPS);
      const float z0 = bf2f((bf16_t)(gz[h] & 0xffff)), z1 = bf2f((bf16_t)(gz[h] >> 16));
      *(unsigned*)(O + (size_t)row * D + 512 + h * 128 + lane * 2) = pack2(o0 * sc * g0 * siluf_(z0), o1 * sc * g1 * siluf_(z1));
    }
  }
}

__device__ __forceinline__ void mixer0_phase(const Params& p, float* sm, int bid, int nb) {
  const int nfox = NB * 8 * 33;
  if (nb > 128) {
    if (bid < 128) {
      gdn_item(p, bid, sm);
    } else {
      for (int f = bid - 128; f < nfox; f += nb - 128) {
        const int qt = 32 - f / 32, bh = f % 32;
        fox_item(p, bh * 33 + qt, sm);
      }
    }
  } else {
    for (int it = bid; it < 128 + nfox; it += nb) {
      if (it < 128) gdn_item(p, it, sm);
      else { const int f = it - 128; const int qt = 32 - f / 32, bh = f % 32; fox_item(p, bh * 33 + qt, sm); }
    }
  }
}

__device__ __forceinline__ bf16_t* yraw_ptr(const Params& p, int b) {
  return (b < 2) ? ((bf16_t*)(p.ws + WS_END) + (size_t)b * LP * D) : ((bf16_t*)((char*)p.out + SZ_O) + (size_t)(b - 2) * LP * D);
}

__device__ __forceinline__ void rwkv_item(const Params& p, int item, float* sm) {
  const int bh = item >> 2, rg = item & 3;
  const int b = bh >> 4, h = bh & 15;
  const bf16_t* rkv = (const bf16_t*)(p.ws + OFF_RKV);
  const bf16_t* aa = (const bf16_t*)p.out;
  const bf16_t* wexp = (const bf16_t*)(p.ws + OFF_O);
  float* SB = (float*)(p.ws + OFF_ZG);
  float* MU = (float*)(p.ws + OFF_MU);
  bf16_t* yr = yraw_ptr(p, b);
  constexpr int TC = 16;
  constexpr int BUF = 5 * TC * 64 + TC * 16 + TC + TC * 16;
  const int tid = otid(), lane = tid & 63, wave = tid >> 6;
  const int sub = lane & 15, rowl = wave * 4 + (lane >> 4);
  const int ltt = tid >> 4, lrr = tid & 15;
  const int ch = h * 64 + lane;
  const float kkw = p.k_k[ch], kaw = p.k_a[ch], rkw = p.r_k[ch];
  const size_t rowb = (size_t)b * LP;
  float S0 = 0.f, S1 = 0.f, S2 = 0.f, S3 = 0.f;
  bf16_t pr0, pr1, pr2, pr3, pk0, pk1, pk2, pk3, pa0, pa1, pa2, pa3, pw0, pw1, pw2, pw3, pv;
#define RW_LOAD1(I, PR, PK, PA, PW)                                        \
  {                                                                        \
    const size_t row = rowb + T0_ + 4 * wave + (I);                        \
    PR = rkv[row * RKLD + ch]; PK = rkv[row * RKLD + 1024 + ch];           \
    PA = aa[row * D + ch]; PW = wexp[row * D + ch];                        \
  }
#define RW_LOAD(T0)                                                        \
  {                                                                        \
    const int T0_ = (T0);                                                  \
    RW_LOAD1(0, pr0, pk0, pa0, pw0) RW_LOAD1(1, pr1, pk1, pa1, pw1)        \
    RW_LOAD1(2, pr2, pk2, pa2, pw2) RW_LOAD1(3, pr3, pk3, pa3, pw3)        \
    pv = rkv[(rowb + T0_ + ltt) * RKLD + 2048 + h * 64 + rg * 16 + lrr];   \
  }
#define RW_PREP1(I, PR, PK, PA, PW)                                        \
  {                                                                        \
    const int t = 4 * wave + (I);                                          \
    const float r = bf2f(PR), kr = bf2f(PK), a = bf2f(PA), we = bf2f(PW);  \
    const float kkv = kr * kkw;                                            \
    const float n2 = wave_sum_fast(kkv * kkv);                             \
    const float kk = kkv * rsqrtf(n2 + EPS);                               \
    const float kp = kr * (1.f + (a - 1.f) * kaw);                         \
    const float sb = wave_sum_fast(r * kp * rkw);                          \
    bb_[0 * TC * 64 + t * 64 + lane] = __expf(-we);                        \
    bb_[1 * TC * 64 + t * 64 + lane] = kp;                                 \
    bb_[2 * TC * 64 + t * 64 + lane] = -kk;                                \
    bb_[3 * TC * 64 + t * 64 + lane] = kk * a;                             \
    bb_[4 * TC * 64 + t * 64 + lane] = r;                                  \
    if (lane == 0 && rg == 0) SB[(rowb + TS_ + t) * 16 + h] = sb;          \
  }
#define RW_STORE(BI, TS)                                                   \
  {                                                                        \
    const int TS_ = (TS);                                                  \
    float* bb_ = sm + (BI) * BUF;                                          \
    RW_PREP1(0, pr0, pk0, pa0, pw0) RW_PREP1(1, pr1, pk1, pa1, pw1)        \
    RW_PREP1(2, pr2, pk2, pa2, pw2) RW_PREP1(3, pr3, pk3, pa3, pw3)        \
    bb_[5 * TC * 64 + ltt * 16 + lrr] = bf2f(pv);                          \
  }
  __syncthreads();
  RW_LOAD(PADR)
  RW_STORE(0, PADR)
  __syncthreads();
  constexpr int NCH = (LP - PADR) / TC;
  for (int c = 0; c < NCH; c++) {
    const int bi = c & 1;
    const int t0 = PADR + c * TC;
    if (c + 1 < NCH) RW_LOAD(t0 + TC)
    {
      const float* bw = sm + bi * BUF;
      const float* bv = bw + 5 * TC * 64;
      float* by = sm + bi * BUF + 5 * TC * 64 + TC * 16 + TC;
      float yreg[TC];
#pragma unroll
      for (int t = 0; t < TC; t++) {
        const float4 w4 = *(const float4*)(bw + 0 * TC * 64 + t * 64 + sub * 4);
        const float4 k4 = *(const float4*)(bw + 1 * TC * 64 + t * 64 + sub * 4);
        const float4 a4 = *(const float4*)(bw + 2 * TC * 64 + t * 64 + sub * 4);
        const float4 b4 = *(const float4*)(bw + 3 * TC * 64 + t * 64 + sub * 4);
        const float4 r4 = *(const float4*)(bw + 4 * TC * 64 + t * 64 + sub * 4);
        const float v = bv[t * 16 + rowl];
        const float sa = dpp_sum16((S0 * a4.x + S1 * a4.y) + (S2 * a4.z + S3 * a4.w));
        S0 = S0 * w4.x + (sa * b4.x + v * k4.x);
        S1 = S1 * w4.y + (sa * b4.y + v * k4.y);
        S2 = S2 * w4.z + (sa * b4.z + v * k4.z);
        S3 = S3 * w4.w + (sa * b4.w + v * k4.w);
        yreg[t] = (S0 * r4.x + S1 * r4.y) + (S2 * r4.z + S3 * r4.w);
      }
#pragma unroll
      for (int t = 0; t < TC; t++) yreg[t] = dpp_sum16(yreg[t]);
      if (sub == 0) {
#pragma unroll
        for (int t = 0; t < TC; t++) by[t * 16 + rowl] = yreg[t];
      }
    }
    if (c + 1 < NCH) RW_STORE(bi ^ 1, t0 + TC)
    __syncthreads();
    {
      const float* bb = sm + bi * BUF;
      const float yv = bb[5 * TC * 64 + TC * 16 + TC + ltt * 16 + lrr];
      const float mu = dpp_sum16(yv) * (1.f / 16.f);
      yr[(size_t)(t0 + ltt) * D + h * 64 + rg * 16 + lrr] = f2bf(yv - mu);
      if (lrr == 0) MU[(rowb + t0 + ltt) * 64 + h * 4 + rg] = mu;
    }
  }
#undef RW_LOAD1
#undef RW_LOAD
#undef RW_PREP1
#undef RW_STORE
  __syncthreads();
}

__device__ __forceinline__ void rwkv_phase(const Params& p, float* sm, int bid, int nb) {
  for (int item = bid; item < 256; item += nb) rwkv_item(p, item, sm);
}

__device__ __forceinline__ void rwkv_gn_phase(const Params& p, int bid, int nb) {
  bf16_t* rkv = (bf16_t*)(p.ws + OFF_RKV);
  const float* SB = (const float*)(p.ws + OFF_ZG);
  const float* MU = (const float*)(p.ws + OFF_MU);
  const int tid_ = otid(); const int lane = tid_ & 63, wave = tid_ >> 6;
  for (int it = bid * 4 + wave; it < R * 16; it += nb * 4) {
    const int row = it >> 4, h = it & 15;
    const int b = row / LP, pr = row - b * LP;
    if (pr < PADR) continue;
    const int ch = h * 64 + lane;
    const float y = bf2f(yraw_ptr(p, b)[(size_t)pr * D + ch]) + MU[(size_t)row * 64 + h * 4 + (lane >> 4)];
    const float v = bf2f(rkv[(size_t)row * RKLD + 2048 + ch]);
    const float sb = SB[(size_t)row * 16 + h];
    const float mean = wave_sum(y) * (1.f / 64.f);
    const float dv = y - mean;
    const float var = wave_sum(dv * dv) * (1.f / 64.f);
    rkv[(size_t)row * RKLD + 2048 + ch] = f2bf(dv * rsqrtf(var + 64e-5f) * p.ln_w[ch] + p.ln_b[ch] + sb * v);
  }
}


#define XB_TMO      128
#define XB_XCNT(j)  (256  + 64 * (j))
#define XB_XSUB(j)  (1280 + 64 * (j))
#define XB_XGEN(j)  (2304 + 64 * (j))
#define XB_TOP      3328
#define XB_TOPGEN   3392
#define XCD_BAR_WORDS 3456
#define XB_SPIN_CAP (1u << 18)
__device__ __forceinline__ unsigned xb_ld(unsigned* p) { return __hip_atomic_load(p, __ATOMIC_RELAXED, __HIP_MEMORY_SCOPE_AGENT); }
__device__ __forceinline__ unsigned xb_add(unsigned* p, unsigned v) { return __hip_atomic_fetch_add(p, v, __ATOMIC_RELAXED, __HIP_MEMORY_SCOPE_AGENT); }
__device__ __forceinline__ unsigned xb_xcc_id() { return (unsigned)__builtin_amdgcn_s_getreg((3 << 11) | 20) & 0xFu; }
#define XB_SPIN(cond, bar) do { unsigned _sp = 0; while (cond) { __builtin_amdgcn_s_sleep(1); \
    if ((++_sp & 255u) == 0u) { if (xb_ld(&(bar)[XB_TMO])) break; if (_sp > XB_SPIN_CAP) { atomicAdd(&(bar)[XB_TMO], 1u); break; } } } } while (0)

__device__ __forceinline__ void xcd_barrier_complete(unsigned* bar, unsigned x, unsigned& nloc, unsigned& nx) {
  const unsigned G = gridDim.x;
  unsigned sum, cnt, mine, sp = 0u;
  for (;;) {
    sum = 0u; cnt = 0u; mine = 0u;
#pragma unroll
    for (unsigned j = 0; j < 16; ++j) { const unsigned c = xb_ld(&bar[XB_XCNT(j)]); sum += c; cnt += (c > 0u) ? 1u : 0u; mine = (j == x) ? c : mine; }
    if (sum == G) break;
    __builtin_amdgcn_s_sleep(1);
    if ((++sp & 255u) == 0u) { if (xb_ld(&bar[XB_TMO])) break; if (sp > XB_SPIN_CAP) { atomicAdd(&bar[XB_TMO], 1u); break; } }
  }
  nloc = mine > 0u ? mine : 1u; nx = cnt > 0u ? cnt : 1u;
}

__device__ __forceinline__ void xcd_barrier(unsigned* bar, unsigned x, unsigned& nloc, unsigned& nx) {
  asm volatile("s_waitcnt vmcnt(0)" ::: "memory");
  __syncthreads();
  if (threadIdx.x == 0) {
    __builtin_amdgcn_s_waitcnt(0);
    if (nloc == 0u) xcd_barrier_complete(bar, x, nloc, nx);
    const unsigned old = xb_add(&bar[XB_XSUB(x)], 1u);
    const unsigned gen = old / nloc;
    if (old + 1u == (gen + 1u) * nloc) {
      __builtin_amdgcn_fence(__ATOMIC_RELEASE, "agent");
      asm volatile("s_waitcnt vmcnt(0)" ::: "memory");
      const unsigned og = xb_add(&bar[XB_TOP], 1u);
      const unsigned tg = og / nx;
      if (og + 1u == (tg + 1u) * nx) xb_add(&bar[XB_TOPGEN], 1u);
      else XB_SPIN(xb_ld(&bar[XB_TOPGEN]) == tg, bar);
      __builtin_amdgcn_fence(__ATOMIC_ACQUIRE, "agent");
      xb_add(&bar[XB_XGEN(x)], 1u);
      asm volatile("s_waitcnt vmcnt(0)" ::: "memory");
    } else {
      XB_SPIN(xb_ld(&bar[XB_XGEN(x)]) == gen, bar);
      __builtin_amdgcn_fence(__ATOMIC_ACQUIRE, "agent");
      asm volatile("s_waitcnt vmcnt(0)" ::: "memory");
    }
  }
  __syncthreads();
}

constexpr int NPHASE = 25;
constexpr int LDS_BYTES = 65536;

__device__ __forceinline__ void run_phase(const Params& p, int ph, char* smraw, int bid, int nb) {
  bf16_t* smb = (bf16_t*)smraw;
  float* smf = (float*)smraw;
  bf16_t* wb = (bf16_t*)(p.ws + OFF_WB);
  bf16_t* wm = (bf16_t*)((char*)p.out + OUT_W1M) - W1_G1;
  float* H = (float*)(p.ws + OFF_H);
  bf16_t* hn = (bf16_t*)p.out + D;
  bf16_t* big = (bf16_t*)(p.ws + OFF_BIG);
  bf16_t* obuf = (bf16_t*)(p.ws + OFF_O);
  bf16_t* mid = (bf16_t*)(p.ws + OFF_MID);
  Epi e; e.f0 = nullptr; e.b0 = nullptr; e.b1 = nullptr; e.v0 = nullptr; e.c0 = nullptr; e.alpha = 0.f;
  e.y01 = nullptr; e.y23 = nullptr; e.mu = nullptr; e.sbp = nullptr; e.lnw = nullptr; e.lnb = nullptr;
  int kind = 7;
  const bf16_t* A = nullptr; int lda = 0; const bf16_t* W = nullptr; int K = 0; int ntn = 0;
  const float* gain = nullptr; int layer = 0;
  switch (ph) {
    case 0: kind = 0; layer = 0; gain = p.ffn_norm + 0 * D; break;
    case 1: kind = 1; W = wb + W0_FIN_A; break;
    case 2: kind = 2; A = big; lda = DFF; W = wb + W0_FOUT_A; K = DFF; e.alpha = 0.5f; break;
    case 3: kind = 3; gain = p.mix_norm + 0 * D; break;
    case 4: kind = 4; break;
    case 5: kind = 5; break;
    case 6: kind = 6; break;
    case 7: kind = 13; break;
    case 8: kind = 2; A = obuf; lda = D; W = wb + W0_HOUT; K = 1024; e.alpha = 1.f; break;
    case 9: kind = 3; gain = p.ffn_norm + 1 * D; break;
    case 10: kind = 1; W = wb + W0_FIN_B; break;
    case 11: kind = 2; A = big; lda = DFF; W = wb + W0_FOUT_B; K = DFF; e.alpha = 0.5f; break;
    case 12: kind = 0; layer = 1; gain = p.ffn_norm + 2 * D; break;
    case 13: kind = 1; W = wb + W1_FIN_A; break;
    case 14: kind = 2; A = big; lda = DFF; W = wb + W1_FOUT_A; K = DFF; e.alpha = 0.5f; break;
    case 15: kind = 3; gain = p.mix_norm + 1 * D; break;
    case 16: kind = 8; break;
    case 17: kind = 9; break;
    case 18: kind = 10; break;
    case 19: kind = 11; break;
    case 20: kind = 2; A = obuf; lda = D; W = wm + W1_WO; K = 1024; e.alpha = 1.f; break;
    case 21: kind = 3; gain = p.ffn_norm + 3 * D; break;
    case 22: kind = 1; W = wb + W1_FIN_B; break;
    case 23: kind = 2; A = big; lda = DFF; W = wb + W1_FOUT_B; K = DFF; e.alpha = 0.5f; break;
    case 24: kind = 12; break;
    default: break;
  }
  bool prep_after = false;
  if (kind == 6) {
    const int rk = ((const int*)(p.ws + OFF_RANK))[bid];
    const int np = (int)*(const unsigned*)(p.ws + OFF_NPRIM);
    if (rk < 0) {
      const int idle_rank = ((const int*)(p.ws + OFF_RANK))[512 + bid];
      prep_weights(p, 1, 1 | 4, smf, idle_rank, nb - np);
      return;
    }
    prep_after = (np >= nb);
    bid = rk; nb = np;
  }
  switch (kind) {
    case 0:
      if (layer == 0) prep_weights(p, 0, 7, smf, bid, nb);
      if (layer == 0) norm_phase<1>(p, gain, hn, bid, nb); else norm_phase<0>(p, gain, hn, bid, nb);
      break;
    case 1: e.b0 = big; gemm_phase<EPI_SWIGLU, false, 256>(hn, D, W, 1024, 44, e, smb, bid, nb); break;
    case 2: e.f0 = H;
      if (nb == 512) {
        gemm_phase<EPI_RESID, false, 256>(A, lda, W, K, 8, e, smb, bid, nb, 0, 1024);
        gemm_phase<EPI_RESID, false>(A, lda, W, K, 8, e, smb, bid, nb, 2048, 2080);
      } else gemm_phase<EPI_RESID, false>(A, lda, W, K, 8, e, smb, bid, nb);
      break;
    case 3: norm_phase<0>(p, gain, hn, bid, nb); break;
    case 4: e.b0 = big; e.f0 = (float*)(p.ws + OFF_ZG); e.b1 = (bf16_t*)(p.ws + OFF_VT);
      gemm_phase<EPI_HYB, false, 256>(hn, D, wb + W0_HIN, 1024, HYB_NP / 128, e, smb, bid, nb); break;
    case 5: hyb_prep_phase(p, smf, bid, nb); break;
#ifndef SKIP_MIX
    case 6: mixer0_phase(p, smf, bid, nb); if (prep_after) { __syncthreads(); prep_weights(p, 1, 1 | 4, smf, bid, nb); } break;
#endif
    case 8: e.b0 = (bf16_t*)(p.ws + OFF_RKV); e.b1 = mid;
      gemm_phase<EPI_RK1, true, 256>(hn, D, wm + W1_G1, 2048, RK_NP / 128, e, smb, bid, nb); break;
    case 9:
      e.b0 = obuf; e.v0 = p.w0;
      gemm_phase<EPI_LW, false>(mid, MIDLD, wm + W1_W2, 64, 8, e, smb, bid, nb);
      e.b0 = (bf16_t*)p.out; e.v0 = p.a0;
      gemm_phase<EPI_LA, false>(mid + 64, MIDLD, wm + W1_A2, 64, 8, e, smb, bid, nb);
      break;
#ifndef SKIP_RWKV
    case 10:
      if (nb == 512 && bid >= 256) prep_weights(p, 1, 2, smf, bid - 256, 256);
      else { if (nb != 512) prep_weights(p, 1, 2, smf, bid, nb); rwkv_phase(p, smf, bid, nb); }
      break;
#endif
    case 11: e.b0 = obuf; e.c0 = (const bf16_t*)(p.ws + OFF_RKV);
      e.y01 = (const bf16_t*)(p.ws + WS_END); e.y23 = (const bf16_t*)((const char*)p.out + SZ_O); e.mu = (const float*)(p.ws + OFF_MU);
      e.sbp = (const float*)(p.ws + OFF_ZG); e.lnw = p.ln_w; e.lnb = p.ln_b;
      gemm_phase<EPI_LG, false>(mid + 128, MIDLD, wm + W1_G2, 192, 8, e, smb, bid, nb); break;
    case 12: final_phase(p, bid, nb); break;
    case 13: gdn_norm_phase(p, bid, nb); break;
    case 14: rwkv_gn_phase(p, bid, nb); break;
    default: break;
  }
}

#if MEGA
__global__ void __launch_bounds__(256, 2) mega_kernel(Params p) {
  __shared__ __attribute__((aligned(16))) char smraw[LDS_BYTES];
  cg::grid_group grid = cg::this_grid();
  unsigned* bar = (unsigned*)(p.ws + OFF_BAR);
  const unsigned xcc = xb_xcc_id();
  unsigned nloc = 0u, nx = 0u;
  if (threadIdx.x == 0) {
    (void)xb_add(&bar[XB_XCNT(xcc)], 1u);
    const unsigned hwid = (unsigned)__builtin_amdgcn_s_getreg((7 << 11) | (8 << 6) | 4);
    const unsigned key = (xcc << 8) | (hwid & 0xFFu);
    unsigned* cucnt = (unsigned*)(p.ws + OFF_CUCNT);
    int rk = -1;
    if (xb_add(&cucnt[key], 1u) == 0u) rk = (int)xb_add((unsigned*)(p.ws + OFF_NPRIM), 1u);
    ((int*)(p.ws + OFF_RANK))[blockIdx.x] = rk;
    ((int*)(p.ws + OFF_RANK))[512 + blockIdx.x] = (rk < 0) ? (int)xb_add((unsigned*)(p.ws + OFF_NPRIM) + 16, 1u) : -1;
  }
  for (int ph = 0; ph < NPHASE; ph++) {
    run_phase(p, ph, smraw, blockIdx.x, gridDim.x);
    if (ph + 1 < NPHASE) {
      if (ph == 0) grid.sync();
      else xcd_barrier(bar, xcc, nloc, nx);
    }
  }
}
#else
template <int PH>
__global__ void __launch_bounds__(256) phase_kernel(Params p) {
  __shared__ __attribute__((aligned(16))) char smraw[LDS_BYTES];
  run_phase(p, PH, smraw, blockIdx.x, gridDim.x);
}
template <int PH>
static void launch_all(const Params& p, hipStream_t stream) {
  if constexpr (PH < NPHASE) {
    if (PH != 7) phase_kernel<PH><<<512, 256, 0, stream>>>(p);
    launch_all<PH + 1>(p, stream);
  }
}
#endif

extern "C" void kernel_launch(void* const* d_in, const int* in_sizes, int n_in, void* d_out, int out_size, void* d_ws,
                              size_t ws_size, hipStream_t stream) {
  Params p{};
  const float** pp = (const float**)&p;
  for (int i = 0; i < 32; i++) pp[i] = (const float*)d_in[i];
  p.out = (float*)d_out;
  p.ws = (char*)d_ws;
#if MEGA
  static int grid_blocks = 0;
  if (!grid_blocks) {
    int dev = 0, cus = 0, per_cu = 0;
    hipGetDevice(&dev);
    hipDeviceGetAttribute(&cus, hipDeviceAttributeMultiprocessorCount, dev);
    hipOccupancyMaxActiveBlocksPerMultiprocessor(&per_cu, mega_kernel, 256, 0);
    if (per_cu > 2) per_cu = 2;
    if (per_cu < 1) per_cu = 1;
    grid_blocks = cus * per_cu;
  }
  hipMemsetAsync((char*)d_ws + OFF_BAR, 0, SZ_SYNC, stream);
  void* args[] = {&p};
  hipError_t err = hipLaunchCooperativeKernel((void*)mega_kernel, dim3(grid_blocks), dim3(256), args, 0, stream);
  if (err != hipSuccess) fprintf(stderr, "cooperative launch failed: %s (grid %d)\n", hipGetErrorString(err), grid_blocks);
#else
  launch_all<0>(p, stream);
#endif
}
```
